# Optimizing an MI355X kernel written in HIP

```python
import math
import jax, jax.numpy as jnp
from jax import lax
import numpy as np

D_MODEL = 1024
BATCH = 16
SEQ = 256
DEPTH = 4
DEC_BATCH = 4
DEC_SEQ = 2048
PAST_LEN = 256

GRID_W = 64
N_HEAD_A = 4
HD_A = 64
DV_A = 2 * HD_A
WIDTH_A = N_HEAD_A * DV_A
N_HEAD_B = 4
DK_B = 128
DV_B = 128
WIDTH_B = N_HEAD_B * DV_B
N_HEAD_C = 8
N_KV_C = 2
HD_C = 64
WIDTH_C = N_HEAD_C * HD_C
N_BRANCH = 3
D_FF = 2816
CHUNK = 64
Q_BLOCK = 128
ROPE_THETA = 10000.0
EPS = 1e-6
COL_SIZES = (
    N_HEAD_A * 2 * HD_A, N_HEAD_A * 2 * HD_A, WIDTH_A,
    N_HEAD_B * DK_B, WIDTH_B, N_HEAD_B * DK_B, N_HEAD_B * DK_B, WIDTH_B,
    WIDTH_C, N_KV_C * HD_C, N_KV_C * HD_C,
    N_BRANCH * D_MODEL,
)
COL_SPLITS = tuple(int(s) for s in np.cumsum(COL_SIZES)[:-1])
D_IN = int(sum(COL_SIZES))

kernel_name = 'hybrid_diffusion_prefix_trunk_step'


def rmsnorm(x, g):
    xf = x.astype(jnp.float32)
    xf = xf * lax.rsqrt(jnp.mean(xf * xf, axis=-1, keepdims=True) + EPS)
    return (xf * g.astype(jnp.float32)).astype(x.dtype)


def modulate(x, g, shift, scale):
    return rmsnorm(x, g) * (1 + scale) + shift


def swiglu(h, wg, wu, wd):
    return (jax.nn.silu(h @ wg) * (h @ wu)) @ wd


def axial_rope(x, rows, cols):
    d = x.shape[-1]
    half = d // 2
    quarter = half // 2
    freqs = ROPE_THETA ** (-jnp.arange(quarter, dtype=jnp.float32) / quarter)
    bshape = (x.shape[1],) + (1,) * (x.ndim - 3) + (quarter,)

    def rot(xa, pos):
        ang = (pos.astype(jnp.float32)[:, None] * freqs).reshape(bshape)
        cos, sin = jnp.cos(ang), jnp.sin(ang)
        x1 = xa[..., :quarter].astype(jnp.float32)
        x2 = xa[..., quarter:].astype(jnp.float32)
        return jnp.concatenate([x1 * cos - x2 * sin, x2 * cos + x1 * sin], axis=-1)

    out = jnp.concatenate([rot(x[..., :half], rows), rot(x[..., half:], cols)], axis=-1)
    return out.astype(x.dtype)


def to_query_blocks(q):
    b, t = q.shape[:2]
    return q.reshape((b, t // Q_BLOCK, Q_BLOCK) + q.shape[2:]).swapaxes(0, 1)


def from_query_blocks(o):
    nb, b = o.shape[:2]
    return o.swapaxes(0, 1).reshape((b, nb * o.shape[2]) + o.shape[3:])


def attend_diff(q, k, v, lam):
    scale = q.shape[-1] ** -0.5

    def blk(qi):
        s = jnp.einsum('bqhcd,bkhcd->bhcqk', qi, k).astype(jnp.float32) * scale
        p = jax.nn.softmax(s, axis=-1)
        w = p[:, :, 0] - lam * p[:, :, 1]
        return jnp.einsum('bhqk,bkhv->bqhv', w.astype(v.dtype), v)

    return from_query_blocks(lax.map(blk, to_query_blocks(q)))


def attend_gqa(q, k, v):
    scale = q.shape[-1] ** -0.5

    def blk(qi):
        s = jnp.einsum('bqhgd,bkhd->bhgqk', qi, k).astype(jnp.float32) * scale
        p = jax.nn.softmax(s, axis=-1)
        return jnp.einsum('bhgqk,bkhd->bqhgd', p.astype(v.dtype), v)

    return from_query_blocks(lax.map(blk, to_query_blocks(q)))


def gla_chunkwise(q, k, v, logf, s0):
    b_, t_, h_, _ = q.shape
    dv = v.shape[-1]
    n = t_ // CHUNK

    def to_chunks(a):
        return a.astype(jnp.float32).reshape(b_, n, CHUNK, h_, a.shape[-1]).transpose(1, 0, 3, 2, 4)

    lower = jnp.tril(jnp.ones((CHUNK, CHUNK), dtype=bool))[:, :, None]

    def step(S, inp):
        qc, kc, vc, gc = inp
        b = jnp.cumsum(gc, axis=2)
        o_inter = jnp.einsum('bhtk,bhkv->bhtv', qc * jnp.exp(b), S)
        decay = jnp.exp(jnp.where(lower, b[:, :, :, None, :] - b[:, :, None, :, :], -jnp.inf))
        scores = jnp.einsum('bhtk,bhtsk,bhsk->bhts', qc, decay, kc)
        o = o_inter + jnp.einsum('bhts,bhsv->bhtv', scores, vc)
        b_end = b[:, :, -1:, :]
        S = jnp.exp(b_end[:, :, 0, :])[..., None] * S + jnp.einsum('bhsk,bhsv->bhkv', kc * jnp.exp(b_end - b), vc)
        return S, o

    s_fin, o = lax.scan(step, s0.astype(jnp.float32), (to_chunks(q), to_chunks(k), to_chunks(v), to_chunks(logf)))
    o = o.transpose(1, 0, 3, 2, 4).reshape(b_, t_, h_, dv)
    return o.astype(v.dtype), s_fin.astype(v.dtype)


def hgrn_lower_bounds(raw):
    cs = jnp.cumsum(jax.nn.softmax(raw.astype(jnp.float32), axis=1), axis=1)
    return cs - cs[:, :1]


def hgrn_gate(z, lb):
    zf = z.astype(jnp.float32)
    logf = jnp.logaddexp(jnp.log(lb), jnp.log1p(-lb) + jax.nn.log_sigmoid(zf))
    k = (1 - lb) * jax.nn.sigmoid(-zf)
    shp = z.shape[:2] + (N_HEAD_B, DK_B)
    return k.reshape(shp), logf.reshape(shp)


def token_mixer(h, p, l, ctx, rows, cols):
    b_, t_, _ = h.shape
    (aq, ak, av, bq, bi, bff, bfb, bg, cq, ck, cv, gts) = jnp.split(h @ p['w_in'][l], COL_SPLITS, axis=-1)
    aq = aq.reshape(b_, t_, N_HEAD_A, 2, HD_A)
    ak = ak.reshape(b_, t_, N_HEAD_A, 2, HD_A)
    av = av.reshape(b_, t_, N_HEAD_A, DV_A)
    cq = rmsnorm(cq.reshape(b_, t_, N_HEAD_C, HD_C), p['gqa_qnorm'][l])
    ck = rmsnorm(ck.reshape(b_, t_, N_KV_C, HD_C), p['gqa_knorm'][l])
    cv = cv.reshape(b_, t_, N_KV_C, HD_C)
    bq = jax.nn.silu(bq.reshape(b_, t_, N_HEAD_B, DK_B)) * (DK_B ** -0.5)
    bi = bi.reshape(b_, t_, N_HEAD_B, DV_B)
    lb = hgrn_lower_bounds(p['hgrn_lb'])
    k_f, logf_f = hgrn_gate(bff, lb[0, l])
    k_b, logf_b = hgrn_gate(bfb, lb[1, l])

    if ctx is None:
        s0f = jnp.zeros((b_, N_HEAD_B, DK_B, DV_B), h.dtype)
        s0b = s0f
        a_keys, a_vals, c_keys, c_vals = ak, av, ck, cv
    else:
        ctx_ak, ctx_av, ctx_s, ctx_ck, ctx_cv = ctx
        aq = axial_rope(aq, rows, cols)
        ak = axial_rope(ak, rows, cols)
        cq = axial_rope(cq, rows, cols)
        ck = axial_rope(ck, rows, cols)
        a_keys = jnp.concatenate([ctx_ak.reshape(b_, -1, N_HEAD_A, 2, HD_A), ak], axis=1)
        a_vals = jnp.concatenate([ctx_av, av], axis=1)
        c_keys = jnp.concatenate([ctx_ck, ck], axis=1)
        c_vals = jnp.concatenate([ctx_cv, cv], axis=1)
        s0f, s0b = ctx_s[:, 0], ctx_s[:, 1]

    lam_init = 0.8 - 0.6 * math.exp(-0.3 * l)
    lp = p['diff_lambda'][l].astype(jnp.float32)
    lam = jnp.exp(jnp.sum(lp[0] * lp[1])) - jnp.exp(jnp.sum(lp[2] * lp[3])) + lam_init
    oa = attend_diff(aq, a_keys, a_vals, lam)
    oa = rmsnorm(oa, p['diff_subln'][l]) * (1 - lam_init)

    of, sf = gla_chunkwise(bq, k_f, bi, logf_f, s0f)
    ob, sb = gla_chunkwise(jnp.flip(bq, 1), jnp.flip(k_b, 1), jnp.flip(bi, 1), jnp.flip(logf_b, 1), s0b)
    obr = of + jnp.flip(ob, 1)
    obr = rmsnorm(obr, p['hgrn_gnorm'][l]) * jax.nn.silu(bg.reshape(b_, t_, N_HEAD_B, DV_B))

    oc = attend_gqa(cq.reshape(b_, t_, N_KV_C, N_HEAD_C // N_KV_C, HD_C), c_keys, c_vals)

    ya = oa.reshape(b_, t_, WIDTH_A) @ p['w_branch_a'][l]
    yb = obr.reshape(b_, t_, WIDTH_B) @ p['w_branch_b'][l]
    yc = oc.reshape(b_, t_, WIDTH_C) @ p['w_branch_c'][l]
    g = jax.nn.sigmoid(gts.reshape(b_, t_, N_BRANCH, D_MODEL))
    merged = g[:, :, 0] * ya + g[:, :, 1] * yb + g[:, :, 2] * yc
    out = merged @ p['w_out'][l]
    if ctx is None:
        new_ctx = (ak.reshape(b_, t_, N_HEAD_A, 2 * HD_A), av, jnp.stack([sf, sb], axis=1), ck, cv)
    else:
        new_ctx = None
    return out, new_ctx


def trunk_layer(x, cond, p, l, ctx, rows, cols):
    mod = jax.nn.silu(cond) @ p['ada_w'][l] + p['ada_b'][l]
    m = jnp.split(mod[:, None, :], 9, axis=-1)
    h = modulate(x, p['norm_pre'][l, 0], m[0], m[1])
    y = swiglu(h, p['ffn_gate'][l, 0], p['ffn_up'][l, 0], p['ffn_down'][l, 0])
    x = x + 0.5 * m[2] * rmsnorm(y, p['norm_post'][l, 0])
    h = modulate(x, p['norm_pre'][l, 1], m[3], m[4])
    y, new_ctx = token_mixer(h, p, l, ctx, rows, cols)
    x = x + m[5] * rmsnorm(y, p['norm_post'][l, 1])
    h = modulate(x, p['norm_pre'][l, 2], m[6], m[7])
    y = swiglu(h, p['ffn_gate'][l, 1], p['ffn_up'][l, 1], p['ffn_down'][l, 1])
    x = x + 0.5 * m[8] * rmsnorm(y, p['norm_post'][l, 2])
    return x, new_ctx


def setup_inputs(seed: int = 0) -> dict:
    key = jax.random.key(seed)
    ks = jax.random.split(key, 32)
    nrm = jax.random.normal
    f32 = jnp.float32
    d = D_MODEL
    return {
        'x_prompt': nrm(ks[0], (BATCH, SEQ, d), f32),
        'x_sample': nrm(ks[1], (DEC_BATCH, DEC_SEQ, d), f32),
        'c': nrm(ks[2], (DEC_BATCH, d), f32),
        'cache_a_k': nrm(ks[3], (DEC_BATCH, DEPTH, PAST_LEN, N_HEAD_A, 2 * HD_A), f32),
        'cache_a_v': nrm(ks[4], (DEC_BATCH, DEPTH, PAST_LEN, N_HEAD_A, DV_A), f32),
        'state_hgrn': nrm(ks[5], (DEC_BATCH, DEPTH, 2, N_HEAD_B, DK_B, DV_B), f32),
        'cache_c_k': nrm(ks[6], (DEC_BATCH, DEPTH, PAST_LEN, N_KV_C, HD_C), f32),
        'cache_c_v': nrm(ks[7], (DEC_BATCH, DEPTH, PAST_LEN, N_KV_C, HD_C), f32),
        'c_ctx': nrm(ks[8], (d,), f32),
        'ada_w': nrm(ks[9], (DEPTH, d, 9 * d), f32) * d ** -0.5,
        'ada_b': 0.02 * nrm(ks[10], (DEPTH, 9 * d), f32),
        'norm_pre': 1.0 + 0.05 * nrm(ks[11], (DEPTH, 3, d), f32),
        'norm_post': 1.0 + 0.05 * nrm(ks[12], (DEPTH, 3, d), f32),
        'ffn_gate': nrm(ks[13], (DEPTH, 2, d, D_FF), f32) * d ** -0.5,
        'ffn_up': nrm(ks[14], (DEPTH, 2, d, D_FF), f32) * d ** -0.5,
        'ffn_down': nrm(ks[15], (DEPTH, 2, D_FF, d), f32) * D_FF ** -0.5,
        'w_in': nrm(ks[16], (DEPTH, d, D_IN), f32) * d ** -0.5,
        'diff_lambda': 0.1 * nrm(ks[17], (DEPTH, 4, HD_A), f32),
        'diff_subln': 1.0 + 0.05 * nrm(ks[18], (DEPTH, DV_A), f32),
        'hgrn_lb': 0.5 * nrm(ks[19], (2, DEPTH, N_HEAD_B * DK_B), f32),
        'hgrn_gnorm': 1.0 + 0.05 * nrm(ks[20], (DEPTH, DV_B), f32),
        'gqa_qnorm': 1.0 + 0.05 * nrm(ks[21], (DEPTH, HD_C), f32),
        'gqa_knorm': 1.0 + 0.05 * nrm(ks[22], (DEPTH, HD_C), f32),
        'w_branch_a': nrm(ks[23], (DEPTH, WIDTH_A, d), f32) * WIDTH_A ** -0.5,
        'w_branch_b': nrm(ks[24], (DEPTH, WIDTH_B, d), f32) * WIDTH_B ** -0.5,
        'w_branch_c': nrm(ks[25], (DEPTH, WIDTH_C, d), f32) * WIDTH_C ** -0.5,
        'w_out': nrm(ks[26], (DEPTH, d, d), f32) * d ** -0.5,
    }


def reference(x_prompt, x_sample, c, cache_a_k, cache_a_v, state_hgrn, cache_c_k, cache_c_v, c_ctx,
              ada_w, ada_b, norm_pre, norm_post, ffn_gate, ffn_up, ffn_down, w_in, diff_lambda, diff_subln,
              hgrn_lb, hgrn_gnorm, gqa_qnorm, gqa_knorm, w_branch_a, w_branch_b, w_branch_c, w_out):
    p = {
        'ada_w': ada_w, 'ada_b': ada_b, 'norm_pre': norm_pre, 'norm_post': norm_post,
        'ffn_gate': ffn_gate, 'ffn_up': ffn_up, 'ffn_down': ffn_down, 'w_in': w_in,
        'diff_lambda': diff_lambda, 'diff_subln': diff_subln, 'hgrn_lb': hgrn_lb, 'hgrn_gnorm': hgrn_gnorm,
        'gqa_qnorm': gqa_qnorm, 'gqa_knorm': gqa_knorm, 'w_branch_a': w_branch_a, 'w_branch_b': w_branch_b,
        'w_branch_c': w_branch_c, 'w_out': w_out,
    }
    n_lat = x_sample.shape[1]
    rows_n = n_lat // GRID_W
    rows = jnp.repeat(jnp.arange(rows_n, dtype=jnp.int32), GRID_W)
    cols = jnp.tile(jnp.arange(GRID_W, dtype=jnp.int32), rows_n)

    xp, xs = x_prompt, x_sample
    new_ak, new_av, new_s, new_ck, new_cv = [], [], [], [], []
    for l in range(DEPTH):
        xp, (ak_l, av_l, s_l, ck_l, cv_l) = trunk_layer(xp, c_ctx[None, :], p, l, None, None, None)
        new_ak.append(ak_l)
        new_av.append(av_l)
        new_s.append(s_l)
        new_ck.append(ck_l)
        new_cv.append(cv_l)
        ctx_l = (cache_a_k[:, l], cache_a_v[:, l], state_hgrn[:, l], cache_c_k[:, l], cache_c_v[:, l])
        xs, _ = trunk_layer(xs, c, p, l, ctx_l, rows, cols)

    new_a_k = jnp.stack(new_ak, axis=1)
    new_a_v = jnp.stack(new_av, axis=1)
    new_hgrn = jnp.stack(new_s, axis=1)
    new_c_k = jnp.stack(new_ck, axis=1)
    new_c_v = jnp.stack(new_cv, axis=1)
    return (xp, xs, new_a_k, new_a_v, new_hgrn, new_c_k, new_c_v)
```

```cpp
#include <hip/hip_runtime.h>
#include <hip/hip_cooperative_groups.h>
#include <cstdio>
#include <cstdint>
namespace cg = cooperative_groups;

typedef unsigned short bf16_t;
typedef short bf16x8 __attribute__((ext_vector_type(8)));
typedef short bf16x4 __attribute__((ext_vector_type(4)));
typedef float f32x16 __attribute__((ext_vector_type(16)));
typedef float f32x4 __attribute__((ext_vector_type(4)));
typedef unsigned u32x4 __attribute__((ext_vector_type(4)));
typedef unsigned u32x2 __attribute__((ext_vector_type(2)));

#define NT 12288
#define NPR 4096
#define DM 1024
#define DFF 2816
#define DIN 7936
#define SLAT 2304
#define SMEM_BYTES 163840
#define NTHR 512
#define EPSV 1e-6f

#define OUT_AK 12582912
#define OUT_AV 20971520
#define OUT_HG 29360128
#define OUT_CK 37748736
#define OUT_CV 39845888

constexpr size_t al256(size_t x) { return (x + 255) & ~(size_t)255; }
constexpr size_t O_WGU = 0;
constexpr size_t O_WD = O_WGU + al256((size_t)4 * 2 * 5632 * 1024 * 2);
constexpr size_t O_WIN = O_WD + al256((size_t)4 * 2 * 1024 * DFF * 2);
constexpr size_t O_WBR = O_WIN + al256((size_t)4 * DIN * 1024 * 2);
constexpr size_t O_WOUT = O_WBR + al256((size_t)4 * 3 * 1024 * 512 * 2);
constexpr size_t O_H = O_WOUT + al256((size_t)4 * 1024 * 1024 * 2);
constexpr size_t O_ACT = O_H + al256((size_t)NT * 1024 * 2);
constexpr size_t O_Y = O_ACT + al256((size_t)NT * 3072 * 2);
constexpr size_t O_OF = O_Y + al256((size_t)NT * 1024 * 4);
constexpr size_t O_OB = O_OF + al256((size_t)NT * 512 * 4);
constexpr size_t O_QA = O_OB + al256((size_t)NT * 512 * 4);
constexpr size_t O_QC = O_QA + al256((size_t)NT * 512 * 2);
constexpr size_t O_KA_ctx = O_QC + al256((size_t)NT * 512 * 2);
constexpr size_t O_VTA_ctx = O_KA_ctx + al256((size_t)NPR * 512 * 2);
constexpr size_t O_KC_ctx = O_VTA_ctx + al256((size_t)NPR * 512 * 2);
constexpr size_t O_VTC_ctx = O_KC_ctx + al256((size_t)NPR * 128 * 2);
constexpr size_t O_KA_lat = O_VTC_ctx + al256((size_t)NPR * 128 * 2);
constexpr size_t O_VTA_lat = O_KA_lat + al256((size_t)4 * SLAT * 512 * 2);
constexpr size_t O_KC_lat = O_VTA_lat + al256((size_t)4 * SLAT * 512 * 2);
constexpr size_t O_VTC_lat = O_KC_lat + al256((size_t)4 * SLAT * 128 * 2);
constexpr size_t O_BQ = O_VTC_lat + al256((size_t)4 * SLAT * 128 * 2);
constexpr size_t O_BI = O_BQ + al256((size_t)NT * 512 * 2);
constexpr size_t O_KKF = O_BI + al256((size_t)NT * 512 * 2);
constexpr size_t O_KKB = O_KKF + al256((size_t)NT * 512 * 2);
constexpr size_t O_BG = O_KKB + al256((size_t)NT * 512 * 2);
constexpr size_t O_LOGFF = O_BG + al256((size_t)NT * 512 * 2);
constexpr size_t O_LOGFB = O_LOGFF + al256((size_t)NT * 512 * 4);
constexpr size_t O_OA = O_LOGFB + al256((size_t)NT * 512 * 4);
constexpr size_t O_OBR = O_OA + al256((size_t)NT * 512 * 2);
constexpr size_t O_OC = O_OBR + al256((size_t)NT * 512 * 2);
constexpr size_t O_MOD = O_OC + al256((size_t)NT * 512 * 2);
constexpr size_t O_LB = O_MOD + al256((size_t)4 * 5 * 9216 * 4);
constexpr size_t O_LAM = O_LB + al256((size_t)2 * 4 * 512 * 4);
constexpr size_t O_ROPE_COS = O_LAM + al256((size_t)256);
constexpr size_t O_ROPE_SIN = O_ROPE_COS + al256((size_t)64 * 16 * 4);
constexpr size_t O_CTR = O_ROPE_SIN + al256((size_t)64 * 16 * 4);
constexpr size_t O_BAR = O_CTR + al256((size_t)256);
constexpr size_t WS_TOTAL = O_BAR + al256((size_t)3456 * 4);
struct Params {
  const float* in[27];
  float* out;
  char* ws;
  __device__ __forceinline__ bf16_t* WGU() const { return (bf16_t*)(ws + O_WGU); }
  __device__ __forceinline__ bf16_t* WD() const { return (bf16_t*)(ws + O_WD); }
  __device__ __forceinline__ bf16_t* WIN() const { return (bf16_t*)(ws + O_WIN); }
  __device__ __forceinline__ bf16_t* WBR() const { return (bf16_t*)(ws + O_WBR); }
  __device__ __forceinline__ bf16_t* WOUT() const { return (bf16_t*)(ws + O_WOUT); }
  __device__ __forceinline__ bf16_t* H() const { return (bf16_t*)(ws + O_H); }
  __device__ __forceinline__ bf16_t* ACT() const { return (bf16_t*)(ws + O_ACT); }
  __device__ __forceinline__ float* Y() const { return (float*)(ws + O_Y); }
  __device__ __forceinline__ float* OF() const { return (float*)(ws + O_OF); }
  __device__ __forceinline__ float* OB() const { return (float*)(ws + O_OB); }
  __device__ __forceinline__ bf16_t* QA() const { return (bf16_t*)(ws + O_QA); }
  __device__ __forceinline__ bf16_t* QC() const { return (bf16_t*)(ws + O_QC); }
  __device__ __forceinline__ bf16_t* KA_ctx() const { return (bf16_t*)(ws + O_KA_ctx); }
  __device__ __forceinline__ bf16_t* VTA_ctx() const { return (bf16_t*)(ws + O_VTA_ctx); }
  __device__ __forceinline__ bf16_t* KC_ctx() const { return (bf16_t*)(ws + O_KC_ctx); }
  __device__ __forceinline__ bf16_t* VTC_ctx() const { return (bf16_t*)(ws + O_VTC_ctx); }
  __device__ __forceinline__ bf16_t* KA_lat() const { return (bf16_t*)(ws + O_KA_lat); }
  __device__ __forceinline__ bf16_t* VTA_lat() const { return (bf16_t*)(ws + O_VTA_lat); }
  __device__ __forceinline__ bf16_t* KC_lat() const { return (bf16_t*)(ws + O_KC_lat); }
  __device__ __forceinline__ bf16_t* VTC_lat() const { return (bf16_t*)(ws + O_VTC_lat); }
  __device__ __forceinline__ bf16_t* BQ() const { return (bf16_t*)(ws + O_BQ); }
  __device__ __forceinline__ bf16_t* BI() const { return (bf16_t*)(ws + O_BI); }
  __device__ __forceinline__ bf16_t* KKF() const { return (bf16_t*)(ws + O_KKF); }
  __device__ __forceinline__ bf16_t* KKB() const { return (bf16_t*)(ws + O_KKB); }
  __device__ __forceinline__ bf16_t* BG() const { return (bf16_t*)(ws + O_BG); }
  __device__ __forceinline__ float* LOGFF() const { return (float*)(ws + O_LOGFF); }
  __device__ __forceinline__ float* LOGFB() const { return (float*)(ws + O_LOGFB); }
  __device__ __forceinline__ bf16_t* OA() const { return (bf16_t*)(ws + O_OA); }
  __device__ __forceinline__ bf16_t* OBR() const { return (bf16_t*)(ws + O_OBR); }
  __device__ __forceinline__ bf16_t* OC() const { return (bf16_t*)(ws + O_OC); }
  __device__ __forceinline__ float* MOD() const { return (float*)(ws + O_MOD); }
  __device__ __forceinline__ float* LB() const { return (float*)(ws + O_LB); }
  __device__ __forceinline__ float* LAM() const { return (float*)(ws + O_LAM); }
  __device__ __forceinline__ float* ROPE_COS() const { return (float*)(ws + O_ROPE_COS); }
  __device__ __forceinline__ float* ROPE_SIN() const { return (float*)(ws + O_ROPE_SIN); }
  __device__ __forceinline__ unsigned* CTR() const { return (unsigned*)(ws + O_CTR); }
  __device__ __forceinline__ unsigned* BAR() const { return (unsigned*)(ws + O_BAR); }
  __device__ __forceinline__ bf16_t* GATE() const { return (bf16_t*)(ws + O_ACT); }
  __device__ __forceinline__ bf16_t* MERGED() const { return (bf16_t*)(ws + O_BQ); }
};
enum { I_XP = 0, I_XS, I_C, I_CAK, I_CAV, I_ST, I_CCK, I_CCV, I_CCTX, I_ADAW, I_ADAB, I_NPRE, I_NPOST, I_FG, I_FU, I_FD, I_WIN,
       I_DLAM, I_SUBLN, I_HLB, I_GNORM, I_QNORM, I_KNORM, I_WBA, I_WBB, I_WBC, I_WOUT };

typedef float f32x2_ __attribute__((ext_vector_type(2)));
typedef __bf16 bf16x2_ __attribute__((ext_vector_type(2)));
__device__ __forceinline__ unsigned pk2(float lo, float hi) {
  const f32x2_ v = {lo, hi};
  const bf16x2_ b = __builtin_convertvector(v, bf16x2_);
  return __builtin_bit_cast(unsigned, b);
}
__device__ __forceinline__ bf16_t f2bf(float f) { return (bf16_t)(pk2(f, 0.f) & 0xffffu); }
__device__ __forceinline__ float bf2f(bf16_t h) { return __uint_as_float(((unsigned)h) << 16); }
__device__ __forceinline__ float sigmoidf_(float x) { return __builtin_amdgcn_rcpf(1.f + __expf(-x)); }
__device__ __forceinline__ float siluf_(float x) { return x * sigmoidf_(x); }
__device__ __forceinline__ float logsigf_(float z) { return -(fmaxf(-z, 0.f) + log1pf(__expf(-fabsf(z)))); }
__device__ __forceinline__ f32x16 mfma32(bf16x8 a, bf16x8 b, f32x16 c) { return __builtin_amdgcn_mfma_f32_32x32x16_bf16(a, b, c, 0, 0, 0); }
__device__ __forceinline__ float wave_sum(float v) {
  v += __shfl_xor(v, 32); v += __shfl_xor(v, 16); v += __shfl_xor(v, 8); v += __shfl_xor(v, 4); v += __shfl_xor(v, 2); v += __shfl_xor(v, 1); return v;
}
__device__ __forceinline__ int opaque_tid() { int t = threadIdx.x; asm volatile("" : "+v"(t)); return t; }
__device__ __forceinline__ void store_bf4(bf16_t* p, float a, float b, float c, float d) { uint2 u; u.x = pk2(a, b); u.y = pk2(c, d); *(uint2*)p = u; }

__device__ __forceinline__ void gemm_kloop(const bf16_t* __restrict__ A, int lda, const bf16_t* __restrict__ Bt, int ldb, int K,
                                           f32x16 (&acc)[2][2], char* smem) {
  const int tid = opaque_tid(), lane = tid & 63, w = tid >> 6, wm = w >> 1, wn = w & 1, l31 = lane & 31, hf = lane >> 5;
  bf16_t* As = (bf16_t*)smem;
  bf16_t* Bs = As + 2 * 256 * 72;
  uint4 ra[4], rb[2];
  const int nk = K >> 6;
  const int r0 = tid >> 3, cc = (tid & 7) * 8;
  const bf16_t* ap = A + (size_t)r0 * lda + cc;
  const bf16_t* bp = Bt + (size_t)r0 * ldb + cc;
#pragma unroll
  for (int i = 0; i < 4; ++i) ra[i] = *(const uint4*)(ap + (size_t)(64 * i) * lda);
#pragma unroll
  for (int i = 0; i < 2; ++i) rb[i] = *(const uint4*)(bp + (size_t)(64 * i) * ldb);
#pragma unroll
  for (int i = 0; i < 4; ++i) *(uint4*)(As + (r0 + 64 * i) * 72 + cc) = ra[i];
#pragma unroll
  for (int i = 0; i < 2; ++i) *(uint4*)(Bs + (r0 + 64 * i) * 72 + cc) = rb[i];
  __syncthreads();
  for (int kt = 0; kt < nk; ++kt) {
    const int buf = kt & 1;
    if (kt + 1 < nk) {
#pragma unroll
      for (int i = 0; i < 4; ++i) ra[i] = *(const uint4*)(ap + (size_t)(64 * i) * lda + (kt + 1) * 64);
#pragma unroll
      for (int i = 0; i < 2; ++i) rb[i] = *(const uint4*)(bp + (size_t)(64 * i) * ldb + (kt + 1) * 64);
    }
    const bf16_t* a = As + buf * 256 * 72 + (wm * 64 + l31) * 72 + hf * 8;
    const bf16_t* b = Bs + buf * 128 * 72 + (wn * 64 + l31) * 72 + hf * 8;
#pragma unroll
    for (int ks = 0; ks < 4; ++ks) {
      bf16x8 a0 = *(const bf16x8*)(a + ks * 16), a1 = *(const bf16x8*)(a + 32 * 72 + ks * 16);
      bf16x8 b0 = *(const bf16x8*)(b + ks * 16), b1 = *(const bf16x8*)(b + 32 * 72 + ks * 16);
      acc[0][0] = mfma32(b0, a0, acc[0][0]); acc[0][1] = mfma32(b1, a0, acc[0][1]);
      acc[1][0] = mfma32(b0, a1, acc[1][0]); acc[1][1] = mfma32(b1, a1, acc[1][1]);
    }
    if (kt + 1 < nk) {
      const int nb = buf ^ 1;
#pragma unroll
      for (int i = 0; i < 4; ++i) *(uint4*)(As + nb * 256 * 72 + (r0 + 64 * i) * 72 + cc) = ra[i];
#pragma unroll
      for (int i = 0; i < 2; ++i) *(uint4*)(Bs + nb * 128 * 72 + (r0 + 64 * i) * 72 + cc) = rb[i];
    }
    __syncthreads();
  }
}

__device__ __forceinline__ bool tile_coords(int t, int nN, int& pm, int& pn) {
  const int per = 8 * nN; const int grp = t / per, within = t - grp * per;
  pm = grp * 8 + (within & 7); pn = within >> 3; return true;
}
__device__ __forceinline__ int virt_block() {
  const int G = gridDim.x; if (G & 7) return blockIdx.x; return (blockIdx.x & 7) * (G >> 3) + (blockIdx.x >> 3);
}
__device__ __forceinline__ void zero_acc(f32x16 (&acc)[2][2]) {
#pragma unroll
  for (int a = 0; a < 2; ++a)
#pragma unroll
    for (int b = 0; b < 2; ++b)
#pragma unroll
      for (int i = 0; i < 16; ++i) acc[a][b][i] = 0.f;
}

__device__ __forceinline__ void phase_gemm_gu(const Params& p, int l, int s, char* smem) {
  const bf16_t* Bt = p.WGU() + (size_t)(l * 2 + s) * 5632 * 1024;
  const int nN = 44, ntiles = 48 * 44, G = gridDim.x;
  const int lane = opaque_tid() & 63, w = opaque_tid() >> 6, wm = w >> 1, wn = w & 1, l31 = lane & 31, hf = lane >> 5;
  for (int t = virt_block(); t < ntiles; t += G) {
    int pm, pn; tile_coords(t, nN, pm, pn);
    f32x16 acc[2][2]; zero_acc(acc);
    gemm_kloop(p.H() + (size_t)pm * 256 * 1024, 1024, Bt + (size_t)pn * 128 * 1024, 1024, 1024, acc, smem);
    const int rowbase = pm * 256 + wm * 64, colbase = pn * 128 + wn * 64;
#pragma unroll
    for (int mi = 0; mi < 2; ++mi) {
      const int token = rowbase + 32 * mi + l31;
#pragma unroll
      for (int g = 0; g < 4; ++g) {
        float o[4];
#pragma unroll
        for (int e = 0; e < 4; ++e) { float gt = acc[mi][0][4 * g + e], up = acc[mi][1][4 * g + e]; o[e] = siluf_(gt) * up; }
        store_bf4(p.ACT() + (size_t)token * DFF + (colbase >> 1) + 8 * g + 4 * hf, o[0], o[1], o[2], o[3]);
      }
    }
  }
}

__device__ __forceinline__ void phase_gemm_y(const Params& p, const bf16_t* A, int K, const bf16_t* Bt, char* smem) {
  const int nN = 8, ntiles = 48 * 8, G = gridDim.x;
  const int lane = opaque_tid() & 63, w = opaque_tid() >> 6, wm = w >> 1, wn = w & 1, l31 = lane & 31, hf = lane >> 5;
  for (int t = virt_block(); t < ntiles; t += G) {
    int pm, pn; tile_coords(t, nN, pm, pn);
    f32x16 acc[2][2]; zero_acc(acc);
    gemm_kloop(A + (size_t)pm * 256 * K, K, Bt + (size_t)pn * 128 * K, K, K, acc, smem);
    const int rowbase = pm * 256 + wm * 64, colbase = pn * 128 + wn * 64;
#pragma unroll
    for (int mi = 0; mi < 2; ++mi) {
      const int token = rowbase + 32 * mi + l31;
#pragma unroll
      for (int ni = 0; ni < 2; ++ni)
#pragma unroll
        for (int g = 0; g < 4; ++g) {
          f32x4 v = {acc[mi][ni][4 * g], acc[mi][ni][4 * g + 1], acc[mi][ni][4 * g + 2], acc[mi][ni][4 * g + 3]};
          *(f32x4*)(p.Y() + (size_t)token * DM + colbase + 32 * ni + 8 * g + 4 * hf) = v;
        }
    }
  }
}

__device__ __forceinline__ void phase_gemm_br(const Params& p, int l, char* smem) {
  const int nN = 8, ntiles = 48 * 8, G = gridDim.x;
  const int lane = opaque_tid() & 63, w = opaque_tid() >> 6, wm = w >> 1, wn = w & 1, l31 = lane & 31, hf = lane >> 5;
  for (int t = virt_block(); t < ntiles; t += G) {
    int pm, pn; tile_coords(t, nN, pm, pn);
    f32x16 tot[2][2]; zero_acc(tot);
    const int rowbase = pm * 256 + wm * 64, colbase = pn * 128 + wn * 64;
#pragma unroll 1
    for (int br = 0; br < 3; ++br) {
      const bf16_t* A = br == 0 ? p.OA() : (br == 1 ? p.OBR() : p.OC());
      const bf16_t* Bt = p.WBR() + (size_t)(l * 3 + br) * 1024 * 512;
      f32x16 acc[2][2]; zero_acc(acc);
      gemm_kloop(A + (size_t)pm * 256 * 512, 512, Bt + (size_t)pn * 128 * 512, 512, 512, acc, smem);
#pragma unroll
      for (int mi = 0; mi < 2; ++mi) {
        const int token = rowbase + 32 * mi + l31;
#pragma unroll
        for (int ni = 0; ni < 2; ++ni)
#pragma unroll
          for (int g = 0; g < 4; ++g) {
            uint2 gv = *(const uint2*)(p.GATE() + (size_t)token * 3072 + br * 1024 + colbase + 32 * ni + 8 * g + 4 * hf);
            tot[mi][ni][4 * g + 0] += __uint_as_float(gv.x << 16) * acc[mi][ni][4 * g + 0];
            tot[mi][ni][4 * g + 1] += __uint_as_float(gv.x & 0xffff0000u) * acc[mi][ni][4 * g + 1];
            tot[mi][ni][4 * g + 2] += __uint_as_float(gv.y << 16) * acc[mi][ni][4 * g + 2];
            tot[mi][ni][4 * g + 3] += __uint_as_float(gv.y & 0xffff0000u) * acc[mi][ni][4 * g + 3];
          }
      }
    }
#pragma unroll
    for (int mi = 0; mi < 2; ++mi) {
      const int token = rowbase + 32 * mi + l31;
#pragma unroll
      for (int ni = 0; ni < 2; ++ni)
#pragma unroll
        for (int g = 0; g < 4; ++g)
          store_bf4(p.MERGED() + (size_t)token * DM + colbase + 32 * ni + 8 * g + 4 * hf, tot[mi][ni][4 * g], tot[mi][ni][4 * g + 1], tot[mi][ni][4 * g + 2], tot[mi][ni][4 * g + 3]);
    }
  }
}

__device__ __forceinline__ void rope_apply(f32x16& a, const float* cs, const float* sn, int pos, int hf) {
#pragma unroll
  for (int gg = 0; gg < 2; ++gg) {
    f32x4 c4 = *(const f32x4*)(cs + pos * 16 + 8 * gg + 4 * hf);
    f32x4 s4 = *(const f32x4*)(sn + pos * 16 + 8 * gg + 4 * hf);
#pragma unroll
    for (int e = 0; e < 4; ++e) {
      const int i = 4 * gg + e; float x1 = a[i], x2 = a[i + 8];
      a[i] = x1 * c4[e] - x2 * s4[e]; a[i + 8] = x2 * c4[e] + x1 * s4[e];
    }
  }
}

namespace pg8 {
#define PG8_LAS __attribute__((address_space(3)))
constexpr int BM = 256, BK = 64, HALF = 128, HTB = HALF * BK * 2, STAGE_BYTES = 8 * HTB, NXCD = 8, WGM = 8;
__device__ __forceinline__ int lds_byte(int r, int c) { const int st = (r >> 4) * 2 + (c >> 5), rr = r & 15, cc = c & 31, ob = rr * 64 + cc * 2; return st * 1024 + (ob ^ (((ob >> 9) & 1) << 5)); }
__device__ __forceinline__ void stage_rc(int b, int& R, int& C) { const int st = b / 1024, sb = b % 1024, swz = sb ^ (((sb >> 9) & 1) << 5); R = (st >> 1) * 16 + swz / 64; C = (st & 1) * 32 + (swz % 64) / 2; }
__device__ __forceinline__ int perm32(int rho) { const int n = rho >> 4, i = rho & 15; return 8 * (i >> 2) + 4 * n + (i & 3); }
struct Unit { int pm, pn, br; };
struct Gemm { const bf16_t* A; const bf16_t* Bt; int M, N, K; };
struct StaticOrder {
    int nM, nN, nwg, G, c;
    __device__ __forceinline__ void init(int M, int N, int G_, int c_) { nM = M / BM; nN = N / BM; nwg = nM * nN; G = G_; c = c_; }
    __device__ __forceinline__ bool next(int i, Unit& u) const {
        const long L = (long)i * G + c; if (L >= nwg) return false;
        int wgid = (int)L; { const int q = nwg / NXCD, r = nwg % NXCD, xcd = wgid % NXCD, off = wgid / NXCD; wgid = (xcd < r ? xcd * (q + 1) : r * (q + 1) + (xcd - r) * q) + off; }
        const int nig = WGM * nN, gid = wgid / nig, fm = gid * WGM, gsz = (nM - fm) < WGM ? (nM - fm) : WGM;
        u.pm = fm + ((wgid % nig) % gsz); u.pn = (wgid % nig) / gsz; u.br = 0; return true;
    }
    __device__ __forceinline__ const char* Aof(const Gemm& g, const Unit& u, size_t tstep) const { return (const char*)g.A + (size_t)u.pm * tstep; }
    __device__ __forceinline__ const char* Bof(const Gemm& g, const Unit& u, size_t tstep) const { return (const char*)g.Bt + (size_t)u.pn * tstep; }
};
struct BranchOrder : StaticOrder {
    size_t strideA, strideB;
    __device__ __forceinline__ bool next(int j, Unit& u) const { const int i = j / 3; if (!StaticOrder::next(i, u)) return false; u.br = j - 3 * i; return true; }
    __device__ __forceinline__ const char* Aof(const Gemm& g, const Unit& u, size_t tstep) const { return (const char*)g.A + (size_t)u.br * strideA + (size_t)u.pm * tstep; }
    __device__ __forceinline__ const char* Bof(const Gemm& g, const Unit& u, size_t tstep) const { return (const char*)g.Bt + (size_t)u.br * strideB + (size_t)u.pn * tstep; }
};
template <class Epi, class Sched>
__device__ __forceinline__ void gemm_phase(PG8_LAS unsigned char* lds, const Gemm g, const Sched& S, const Epi& E) {
    const int tid = opaque_tid(), wid = __builtin_amdgcn_readfirstlane(tid >> 6), lane = tid & 63, wr = wid >> 2, wc = wid & 3, fr = lane & 15, fq = lane >> 4;
    const int K = g.K, nt = K / BK;
    unsigned voffA[2], voffB[2];
#pragma unroll
    for (int i = 0; i < 2; ++i) { int R, C; stage_rc(tid * 16 + i * 8192, R, C); const int Rb = Epi::PERM ? ((R & ~31) + perm32(R & 31)) : R;
        voffA[i] = (unsigned)(R * K + C) * 2u; voffB[i] = (unsigned)(Rb * K + C) * 2u; }
    const size_t kstep = (size_t)(BK * 2);
    const size_t hstep = (size_t)HALF * K * 2;
    const size_t tstep = 2 * hstep;
    const unsigned ldsw = (unsigned)wid * 1024u;
    const int aoff = lds_byte(wr * 64 + fr, fq * 8), boff = lds_byte(wc * 32 + fr, fq * 8);
#define PG8_SA(b, h) (((b) * 2 + (h)) * HTB)
#define PG8_SB(b, h) ((4 + (b) * 2 + (h)) * HTB)
#define PG8_STAGE(bufoff, gbase, voff) do { _Pragma("unroll") for (int _i = 0; _i < 2; ++_i) \
        __builtin_amdgcn_global_load_lds((const unsigned*)((const char*)(gbase) + (voff)[_i]), (PG8_LAS unsigned*)(lds + (bufoff) + ldsw + _i * 8192), 16, 0, 0); } while (0)
#define PG8_LDA(dst, b, h) do { _Pragma("unroll") for (int m = 0; m < 4; ++m) _Pragma("unroll") for (int k = 0; k < 2; ++k) dst[m][k] = *(const PG8_LAS bf16x8*)(lds + PG8_SA(b, h) + aoff + m * 2048 + k * 1024); } while (0)
#define PG8_LDB(dst, b, h) do { _Pragma("unroll") for (int n = 0; n < 2; ++n) _Pragma("unroll") for (int k = 0; k < 2; ++k) dst[n][k] = *(const PG8_LAS bf16x8*)(lds + PG8_SB(b, h) + boff + n * 2048 + k * 1024); } while (0)
#define PG8_MMA(ai, bj, At, Bt) do { __builtin_amdgcn_s_setprio(1); _Pragma("unroll") for (int m = 0; m < 4; ++m) _Pragma("unroll") for (int n = 0; n < 2; ++n) _Pragma("unroll") for (int k = 0; k < 2; ++k) \
        acc[ai][bj][m][n] = __builtin_amdgcn_mfma_f32_16x16x32_bf16(Bt[n][k], At[m][k], acc[ai][bj][m][n], 0, 0, 0); __builtin_amdgcn_s_setprio(0); } while (0)
#define PG8_WAIT_V(n) asm volatile("s_waitcnt vmcnt(" #n ")" ::: "memory")
#define PG8_WAIT_L(n) asm volatile("s_waitcnt lgkmcnt(" #n ")" ::: "memory")
#define PG8_BAR __builtin_amdgcn_s_barrier()
#define PG8_SCHED __builtin_amdgcn_sched_barrier(0)
    Unit cur, nxt; int ui = 0;
    if (!S.next(0, cur)) return;
    f32x4 acc[2][2][4][2];
#pragma unroll
    for (int a = 0; a < 2; ++a)
#pragma unroll
        for (int b = 0; b < 2; ++b)
#pragma unroll
            for (int m = 0; m < 4; ++m)
#pragma unroll
                for (int n = 0; n < 2; ++n) acc[a][b][m][n] = (f32x4){0.f, 0.f, 0.f, 0.f};
    bf16x8 At[4][2], B0[2][2], B1[2][2];
    const char* cA = S.Aof(g, cur, tstep); const char* cB = S.Bof(g, cur, tstep);
    PG8_STAGE(PG8_SB(0, 0), cB, voffB); PG8_STAGE(PG8_SA(0, 0), cA, voffA); PG8_STAGE(PG8_SB(0, 1), cB + hstep, voffB); PG8_STAGE(PG8_SA(0, 1), cA + hstep, voffA);
    if (wr == 1) PG8_BAR;
    PG8_WAIT_V(4); PG8_BAR;
    PG8_STAGE(PG8_SB(1, 0), cB + kstep, voffB); PG8_STAGE(PG8_SA(1, 0), cA + kstep, voffA); PG8_STAGE(PG8_SB(1, 1), cB + hstep + kstep, voffB);
    PG8_WAIT_V(6); PG8_BAR;
    for (;;) {
        const bool has_next = S.next(ui + 1, nxt);
        const char* nA = has_next ? S.Aof(g, nxt, tstep) : cA; const char* nB = has_next ? S.Bof(g, nxt, tstep) : cB;
        for (int t = 0; t < nt; t += 2) {
            const bool last = (t == nt - 2);
            const char* a1 = cA + (size_t)(t + 1) * kstep;
            const char* a2 = last ? nA : cA + (size_t)(t + 2) * kstep; const char* b2 = last ? nB : cB + (size_t)(t + 2) * kstep;
            const char* a3 = a2 + kstep; const char* b3 = b2 + kstep;
            PG8_LDB(B0, 0, 0); PG8_SCHED; PG8_LDA(At, 0, 0); PG8_STAGE(PG8_SA(1, 1), a1 + hstep, voffA);
            PG8_WAIT_L(8); PG8_BAR; PG8_WAIT_L(0); PG8_MMA(0, 0, At, B0); PG8_BAR; PG8_SCHED;
            PG8_LDB(B1, 0, 1); PG8_STAGE(PG8_SB(0, 0), b2, voffB);
            PG8_BAR; PG8_WAIT_L(0); PG8_MMA(0, 1, At, B1); PG8_BAR;
            PG8_LDA(At, 0, 1); PG8_STAGE(PG8_SA(0, 0), a2, voffA);
            PG8_BAR; PG8_WAIT_L(0); PG8_MMA(1, 0, At, B0); PG8_BAR; PG8_SCHED;
            PG8_STAGE(PG8_SB(0, 1), b2 + hstep, voffB);
            PG8_WAIT_V(6); PG8_BAR; PG8_MMA(1, 1, At, B1); PG8_BAR;
            PG8_LDB(B0, 1, 0); PG8_SCHED; PG8_LDA(At, 1, 0); PG8_STAGE(PG8_SA(0, 1), a2 + hstep, voffA);
            PG8_WAIT_L(8); PG8_BAR; PG8_WAIT_L(0); PG8_MMA(0, 0, At, B0); PG8_BAR; PG8_SCHED;
            PG8_LDB(B1, 1, 1); PG8_STAGE(PG8_SB(1, 0), b3, voffB);
            PG8_BAR; PG8_WAIT_L(0); PG8_MMA(0, 1, At, B1); PG8_BAR;
            PG8_LDA(At, 1, 1); PG8_STAGE(PG8_SA(1, 0), a3, voffA);
            PG8_BAR; PG8_WAIT_L(0); PG8_MMA(1, 0, At, B0); PG8_BAR; PG8_SCHED;
            PG8_STAGE(PG8_SB(1, 1), b3 + hstep, voffB);
            PG8_WAIT_V(6); PG8_BAR; PG8_MMA(1, 1, At, B1); PG8_BAR;
        }
        if constexpr (Epi::CHAIN) E.chain(acc, cur, wr, wc, fr, fq); else E(acc, cur, wr, wc, fr, fq);
        if (!has_next) break;
        if (!(Epi::CHAIN && cur.br < 2)) {
#pragma unroll
        for (int a = 0; a < 2; ++a)
#pragma unroll
            for (int b = 0; b < 2; ++b)
#pragma unroll
                for (int m = 0; m < 4; ++m)
#pragma unroll
                    for (int n = 0; n < 2; ++n) acc[a][b][m][n] = (f32x4){0.f, 0.f, 0.f, 0.f};
        }
        cur = nxt; cA = nA; cB = nB; ++ui;
    }
    PG8_WAIT_V(0);
    if (wr == 0) PG8_BAR;
    PG8_BAR;
#undef PG8_SA
#undef PG8_SB
#undef PG8_STAGE
#undef PG8_LDA
#undef PG8_LDB
#undef PG8_MMA
#undef PG8_WAIT_V
#undef PG8_WAIT_L
#undef PG8_BAR
#undef PG8_SCHED
}
}

struct EpiGU {
  static constexpr bool PERM = true, CHAIN = false;
  bf16_t* ACT;
  __device__ __forceinline__ void operator()(const f32x4 (&acc)[2][2][4][2], const pg8::Unit& u, int wr, int wc, int fr, int fq) const {
#pragma unroll
    for (int ai = 0; ai < 2; ++ai)
#pragma unroll
      for (int m = 0; m < 4; ++m) {
        const int row = u.pm * 256 + ai * 128 + wr * 64 + m * 16 + fr;
        const int f = 128 * u.pn + 32 * wc + 8 * fq;
        const f32x4 g0 = acc[ai][0][m][0], g1 = acc[ai][0][m][1], u0 = acc[ai][1][m][0], u1 = acc[ai][1][m][1];
        u32x4 o;
        o.x = pk2(siluf_(g0[0]) * u0[0], siluf_(g0[1]) * u0[1]); o.y = pk2(siluf_(g0[2]) * u0[2], siluf_(g0[3]) * u0[3]);
        o.z = pk2(siluf_(g1[0]) * u1[0], siluf_(g1[1]) * u1[1]); o.w = pk2(siluf_(g1[2]) * u1[2], siluf_(g1[3]) * u1[3]);
        *(u32x4*)(ACT + (size_t)row * DFF + f) = o;
      }
  }
};
struct EpiY {
  static constexpr bool PERM = true, CHAIN = false;
  bf16_t* Y;
  __device__ __forceinline__ void operator()(const f32x4 (&acc)[2][2][4][2], const pg8::Unit& u, int wr, int wc, int fr, int fq) const {
#pragma unroll
    for (int ai = 0; ai < 2; ++ai)
#pragma unroll
      for (int m = 0; m < 4; ++m) {
        bf16_t* rp = Y + (size_t)(u.pm * 256 + ai * 128 + wr * 64 + m * 16 + fr) * DM + u.pn * 256 + wc * 32 + 8 * fq;
#pragma unroll
        for (int bj = 0; bj < 2; ++bj) {
          const f32x4 t0 = acc[ai][bj][m][0], t1 = acc[ai][bj][m][1];
          u32x4 o; o.x = pk2(t0[0], t0[1]); o.y = pk2(t0[2], t0[3]); o.z = pk2(t1[0], t1[1]); o.w = pk2(t1[2], t1[3]);
          *(u32x4*)(rp + bj * 128) = o;
        }
      }
  }
};
struct EpiBR {
  static constexpr bool PERM = true, CHAIN = true;
  const bf16_t* GATE; bf16_t* MERGED;
  __device__ __forceinline__ void chain(f32x4 (&acc)[2][2][4][2], const pg8::Unit& u, int wr, int wc, int fr, int fq) const {
#pragma unroll
    for (int ai = 0; ai < 2; ++ai)
#pragma unroll
      for (int m = 0; m < 4; ++m) {
        const size_t row = (size_t)(u.pm * 256 + ai * 128 + wr * 64 + m * 16 + fr);
#pragma unroll
        for (int bj = 0; bj < 2; ++bj) {
          const int col = u.pn * 256 + bj * 128 + wc * 32 + 8 * fq;
          const bf16_t* gp = GATE + row * 3072 + u.br * 1024 + col;
          const u32x4 gv = *(const u32x4*)gp;
          float g[8] = {__uint_as_float(gv.x << 16), __uint_as_float(gv.x & 0xffff0000u), __uint_as_float(gv.y << 16), __uint_as_float(gv.y & 0xffff0000u),
                        __uint_as_float(gv.z << 16), __uint_as_float(gv.z & 0xffff0000u), __uint_as_float(gv.w << 16), __uint_as_float(gv.w & 0xffff0000u)};
          if (u.br < 2) {
            const u32x4 hv = *(const u32x4*)(gp + 1024);
            const float h[8] = {__uint_as_float(hv.x << 16), __uint_as_float(hv.x & 0xffff0000u), __uint_as_float(hv.y << 16), __uint_as_float(hv.y & 0xffff0000u),
                                __uint_as_float(hv.z << 16), __uint_as_float(hv.z & 0xffff0000u), __uint_as_float(hv.w << 16), __uint_as_float(hv.w & 0xffff0000u)};
#pragma unroll
            for (int e = 0; e < 8; ++e) g[e] = fmaxf(g[e], 1e-30f) * __builtin_amdgcn_rcpf(fmaxf(h[e], 1e-30f));
          } else {
#pragma unroll
            for (int e = 0; e < 8; ++e) g[e] = fmaxf(g[e], 1e-30f);
          }
          f32x4 t0 = acc[ai][bj][m][0], t1 = acc[ai][bj][m][1];
          t0[0] *= g[0]; t0[1] *= g[1]; t0[2] *= g[2]; t0[3] *= g[3]; t1[0] *= g[4]; t1[1] *= g[5]; t1[2] *= g[6]; t1[3] *= g[7];
          if (u.br < 2) { acc[ai][bj][m][0] = t0; acc[ai][bj][m][1] = t1; }
          else { u32x4 o; o.x = pk2(t0[0], t0[1]); o.y = pk2(t0[2], t0[3]); o.z = pk2(t1[0], t1[1]); o.w = pk2(t1[2], t1[3]); *(u32x4*)(MERGED + row * DM + col) = o; }
        }
      }
  }
};
template <int TY> __device__ __forceinline__ void win_epi_row(const Params& p, int l, bool lat, int token, int G0, int fq, f32x4 v0, f32x4 v1, f32x4 v2, f32x4 v3) {
  if (TY == 0) __builtin_assume(G0 < 1024);
  if (TY == 1) __builtin_assume(G0 >= 1024 && G0 < 1536);
  if (TY == 2) __builtin_assume(G0 >= 1536 && G0 < 4096);
  if (TY == 3) __builtin_assume(G0 >= 4096 && G0 < 4736);
  if (TY == 4) __builtin_assume(G0 >= 4736 && G0 < 4864);
  if (TY == 5) __builtin_assume(G0 >= 4864);
  f32x4 v[4] = {v0, v1, v2, v3};
  int b, tt;
  if (lat) { b = (token - NPR) >> 11; tt = (token - NPR) & 2047; } else { b = token >> 8; tt = token & 255; }
  const bool isn = (G0 >= 4096 && G0 < 4736);
  if (isn) {
    float ss = 0.f;
#pragma unroll
    for (int j = 0; j < 4; ++j) ss += v[j][0] * v[j][0] + v[j][1] * v[j][1] + v[j][2] * v[j][2] + v[j][3] * v[j][3];
    ss += __shfl_xor(ss, 16); ss += __shfl_xor(ss, 32);
    const float r = rsqrtf(ss * (1.f / 64.f) + EPSV);
    const float* nw = p.in[G0 < 4608 ? I_QNORM : I_KNORM] + l * 64;
#pragma unroll
    for (int j = 0; j < 4; ++j) {
      const f32x4 w4 = *(const f32x4*)(nw + 16 * j + 4 * fq);
      v[j][0] *= r * w4[0]; v[j][1] *= r * w4[1]; v[j][2] *= r * w4[2]; v[j][3] *= r * w4[3];
    }
  }
  if (lat && (G0 < 1024 || isn)) {
#pragma unroll
    for (int bj = 0; bj < 2; ++bj) {
      const int pos = bj ? (tt & 63) : (tt >> 6);
      const f32x4 c4 = *(const f32x4*)(p.ROPE_COS() + pos * 16 + 4 * fq), s4 = *(const f32x4*)(p.ROPE_SIN() + pos * 16 + 4 * fq);
#pragma unroll
      for (int e = 0; e < 4; ++e) {
        const float x1 = v[2 * bj][e], x2 = v[2 * bj + 1][e];
        v[2 * bj][e] = x1 * c4[e] - x2 * s4[e]; v[2 * bj + 1][e] = x2 * c4[e] + x1 * s4[e];
      }
    }
  }
#pragma unroll
  for (int j = 0; j < 4; ++j) {
    const int col = G0 + 16 * j + 4 * fq;
    const f32x4 x = v[j];
    if (G0 < 512) {
      store_bf4(p.QA() + (size_t)token * 512 + col, x[0], x[1], x[2], x[3]);
    } else if (G0 < 1024) {
      const int c = col - 512;
      bf16_t* kd = lat ? p.KA_lat() + ((size_t)b * SLAT + 256 + tt) * 512 : p.KA_ctx() + (size_t)token * 512;
      store_bf4(kd + c, x[0], x[1], x[2], x[3]);
      if (!lat) *(f32x4*)(p.out + OUT_AK + ((size_t)(b * 4 + l) * 256 + tt) * 512 + c) = x;
    } else if (G0 < 1536) {
      const int c = col - 1024;
      const int S = lat ? SLAT : 256; const int key = lat ? 256 + tt : tt;
      bf16_t* vt = lat ? p.VTA_lat() : p.VTA_ctx();
      const unsigned vo = (unsigned)(b * 512 + c) * (unsigned)S + (unsigned)key;
      if (!lat) *(f32x4*)(p.out + OUT_AV + ((size_t)(b * 4 + l) * 256 + tt) * 512 + c) = x;
#pragma unroll
      for (int e = 0; e < 4; ++e) vt[vo + (unsigned)(e * S)] = f2bf(x[e]);
    } else if (G0 < 4096) {
      const int kind = (G0 - 1536) >> 9;
      const int c = (col - 1536) & 511;
      const size_t off = (size_t)token * 512 + c;
      if (kind == 0) {
        store_bf4(p.BQ() + off, siluf_(x[0]) * 0.08838834764831845f, siluf_(x[1]) * 0.08838834764831845f, siluf_(x[2]) * 0.08838834764831845f, siluf_(x[3]) * 0.08838834764831845f);
      } else if (kind == 1) {
        store_bf4(p.BI() + off, x[0], x[1], x[2], x[3]);
      } else if (kind == 4) {
        store_bf4(p.BG() + off, siluf_(x[0]), siluf_(x[1]), siluf_(x[2]), siluf_(x[3]));
      } else {
        const int d = kind - 2;
        const f32x4 lb4 = *(const f32x4*)(p.LB() + (d * 4 + l) * 512 + c);
        float kk[4], lf[4];
#pragma unroll
        for (int e = 0; e < 4; ++e) {
          const float z = x[e], lb = lb4[e];
          kk[e] = (1.f - lb) * __builtin_amdgcn_rcpf(1.f + __expf(z));
          const float ls = -(fmaxf(-z, 0.f) + __logf(1.f + __expf(-fabsf(z))));
          lf[e] = (lb <= 0.f) ? ls : __logf(lb + (1.f - lb) * __builtin_amdgcn_rcpf(1.f + __expf(-z)));
        }
        store_bf4((d ? p.KKB() : p.KKF()) + off, kk[0], kk[1], kk[2], kk[3]);
        *(f32x4*)((d ? p.LOGFB() : p.LOGFF()) + off) = (f32x4){lf[0], lf[1], lf[2], lf[3]};
      }
    } else if (G0 < 4608) {
      store_bf4(p.QC() + (size_t)token * 512 + col - 4096, x[0], x[1], x[2], x[3]);
    } else if (G0 < 4736) {
      const int c = col - 4608;
      bf16_t* kd = lat ? p.KC_lat() + ((size_t)b * SLAT + 256 + tt) * 128 : p.KC_ctx() + (size_t)token * 128;
      store_bf4(kd + c, x[0], x[1], x[2], x[3]);
      if (!lat) *(f32x4*)(p.out + OUT_CK + ((size_t)(b * 4 + l) * 256 + tt) * 128 + c) = x;
    } else if (G0 < 4864) {
      const int c = col - 4736;
      const int S = lat ? SLAT : 256; const int key = lat ? 256 + tt : tt;
      bf16_t* vt = lat ? p.VTC_lat() : p.VTC_ctx();
      const unsigned vo = (unsigned)(b * 128 + c) * (unsigned)S + (unsigned)key;
      if (!lat) *(f32x4*)(p.out + OUT_CV + ((size_t)(b * 4 + l) * 256 + tt) * 128 + c) = x;
#pragma unroll
      for (int e = 0; e < 4; ++e) vt[vo + (unsigned)(e * S)] = f2bf(x[e]);
    } else {
      store_bf4(p.GATE() + (size_t)token * 3072 + col - 4864, sigmoidf_(x[0]), sigmoidf_(x[1]), sigmoidf_(x[2]), sigmoidf_(x[3]));
    }
  }
}
struct EpiWIN {
  static constexpr bool PERM = false, CHAIN = false;
  const Params& p; int l;
  __device__ __forceinline__ void operator()(const f32x4 (&acc)[2][2][4][2], const pg8::Unit& u, int wr, int wc, int fr, int fq) const {
    const int G0 = u.pn * 256 + wc * 64;
    const int row0 = u.pm * 256 + wr * 64 + fr;
    const bool lat = u.pm >= 16;
#define WIN_ROW(TY, ai, m) win_epi_row<TY>(p, l, lat, row0 + (ai) * 128 + (m) * 16, G0, fq, acc[ai][0][m][0], acc[ai][0][m][1], acc[ai][1][m][0], acc[ai][1][m][1]);
#define WIN_ROWS(TY) { WIN_ROW(TY, 0, 0) WIN_ROW(TY, 0, 1) WIN_ROW(TY, 0, 2) WIN_ROW(TY, 0, 3) WIN_ROW(TY, 1, 0) WIN_ROW(TY, 1, 1) WIN_ROW(TY, 1, 2) WIN_ROW(TY, 1, 3) }
    if (G0 < 1024) WIN_ROWS(0)
    else if (G0 < 1536) WIN_ROWS(1)
    else if (G0 < 4096) WIN_ROWS(2)
    else if (G0 < 4736) WIN_ROWS(3)
    else if (G0 < 4864) WIN_ROWS(4)
    else WIN_ROWS(5)
#undef WIN_ROWS
#undef WIN_ROW
  }
};

__device__ __forceinline__ void phase_gemm_gu2(const Params& p, int l, int s, PG8_LAS unsigned char* lds) {
  pg8::Gemm g{p.H(), p.WGU() + (size_t)(l * 2 + s) * 5632 * 1024, NT, 5632, 1024};
  pg8::StaticOrder S; S.init(NT, 5632, (int)gridDim.x, (int)blockIdx.x);
  EpiGU E{p.ACT()};
  pg8::gemm_phase<EpiGU, pg8::StaticOrder>(lds, g, S, E);
}
__device__ __forceinline__ void phase_gemm_y2(const Params& p, const bf16_t* A, int K, const bf16_t* Bt, PG8_LAS unsigned char* lds) {
  pg8::Gemm g{A, Bt, NT, 1024, K};
  pg8::StaticOrder S; S.init(NT, 1024, (int)gridDim.x, (int)blockIdx.x);
  EpiY E{(bf16_t*)p.Y()};
  pg8::gemm_phase<EpiY, pg8::StaticOrder>(lds, g, S, E);
}
__device__ __forceinline__ void phase_gemm_win2(const Params& p, int l, PG8_LAS unsigned char* lds) {
  pg8::Gemm g{p.H(), p.WIN() + (size_t)l * DIN * 1024, NT, DIN, 1024};
  pg8::StaticOrder S; S.init(NT, DIN, (int)gridDim.x, (int)blockIdx.x);
  EpiWIN E{p, l};
  pg8::gemm_phase<EpiWIN, pg8::StaticOrder>(lds, g, S, E);
}

__device__ __forceinline__ void phase_gemm_br2(const Params& p, int l, PG8_LAS unsigned char* lds) {
  pg8::Gemm g{p.OA(), p.WBR() + (size_t)l * 3 * 1024 * 512, NT, 1024, 512};
  pg8::BranchOrder S; S.init(NT, 1024, (int)gridDim.x, (int)blockIdx.x);
  S.strideA = O_OBR - O_OA; S.strideB = (size_t)1024 * 512 * 2;
  EpiBR E{p.GATE(), p.MERGED()};
  pg8::gemm_phase<EpiBR, pg8::BranchOrder>(lds, g, S, E);
}

__device__ __forceinline__ void phase_rowwise(const Params& p, bool first, int lpost, int spost, float coef, int cgate, int lpre, int spre, int cshift, int cscale) {
  const int lane = opaque_tid() & 63, w = opaque_tid() >> 6;
  for (int grp = blockIdx.x; grp < NT / 8; grp += gridDim.x) {
    const int row = grp * 8 + w;
    const int ci = row < NPR ? 0 : 1 + ((row - NPR) >> 11);
    f32x4 x[4];
    float* X = p.out + (size_t)row * DM;
    if (first) {
      const float* src = row < NPR ? p.in[I_XP] + (size_t)row * DM : p.in[I_XS] + (size_t)(row - NPR) * DM;
#pragma unroll
      for (int j = 0; j < 4; ++j) x[j] = *(const f32x4*)(src + lane * 4 + 256 * j);
    } else {
#pragma unroll
      for (int j = 0; j < 4; ++j) x[j] = *(const f32x4*)(X + lane * 4 + 256 * j);
    }
    if (lpost >= 0) {
      f32x4 y[4]; float ss = 0.f;
#pragma unroll
      for (int j = 0; j < 4; ++j) { const u32x2 yr = *(const u32x2*)((const bf16_t*)p.Y() + (size_t)row * DM + lane * 4 + 256 * j); y[j][0] = __uint_as_float(yr.x << 16); y[j][1] = __uint_as_float(yr.x & 0xffff0000u); y[j][2] = __uint_as_float(yr.y << 16); y[j][3] = __uint_as_float(yr.y & 0xffff0000u); ss += y[j][0] * y[j][0] + y[j][1] * y[j][1] + y[j][2] * y[j][2] + y[j][3] * y[j][3]; }
      ss = wave_sum(ss);
      const float r = rsqrtf(ss * (1.f / 1024.f) + EPSV) * coef;
      const float* md = p.MOD() + (size_t)(lpost * 5 + ci) * 9216 + cgate * 1024;
      const float* gp = p.in[I_NPOST] + (lpost * 3 + spost) * 1024;
#pragma unroll
      for (int j = 0; j < 4; ++j) {
        f32x4 m4 = *(const f32x4*)(md + lane * 4 + 256 * j), g4 = *(const f32x4*)(gp + lane * 4 + 256 * j);
#pragma unroll
        for (int e = 0; e < 4; ++e) x[j][e] += m4[e] * (y[j][e] * r * g4[e]);
      }
    }
    if (first || lpost >= 0) {
#pragma unroll
      for (int j = 0; j < 4; ++j) *(f32x4*)(X + lane * 4 + 256 * j) = x[j];
    }
    if (lpre >= 0) {
      float ss = 0.f;
#pragma unroll
      for (int j = 0; j < 4; ++j) ss += x[j][0] * x[j][0] + x[j][1] * x[j][1] + x[j][2] * x[j][2] + x[j][3] * x[j][3];
      ss = wave_sum(ss);
      const float r = rsqrtf(ss * (1.f / 1024.f) + EPSV);
      const float* msh = p.MOD() + (size_t)(lpre * 5 + ci) * 9216 + cshift * 1024;
      const float* msc = p.MOD() + (size_t)(lpre * 5 + ci) * 9216 + cscale * 1024;
      const float* gp = p.in[I_NPRE] + (lpre * 3 + spre) * 1024;
#pragma unroll
      for (int j = 0; j < 4; ++j) {
        f32x4 sh = *(const f32x4*)(msh + lane * 4 + 256 * j), sc = *(const f32x4*)(msc + lane * 4 + 256 * j), g4 = *(const f32x4*)(gp + lane * 4 + 256 * j);
        float h[4];
#pragma unroll
        for (int e = 0; e < 4; ++e) h[e] = x[j][e] * r * g4[e] * (1.f + sc[e]) + sh[e];
        store_bf4(p.H() + (size_t)row * DM + lane * 4 + 256 * j, h[0], h[1], h[2], h[3]);
      }
    }
  }
}

__device__ __forceinline__ void cache_convert(const Params& p, int l) {
  const int gtid = blockIdx.x * NTHR + opaque_tid(), gsz = gridDim.x * NTHR;
  for (int i = gtid; i < 4 * 256 * 512; i += gsz) {
    const int c = i & 511, s = (i >> 9) & 255, b = i >> 17;
    const size_t src = ((size_t)(b * 4 + l) * 256 + s) * 512 + c;
    p.KA_lat()[((size_t)b * SLAT + s) * 512 + c] = f2bf(p.in[I_CAK][src]);
    p.VTA_lat()[((size_t)b * 512 + c) * SLAT + s] = f2bf(p.in[I_CAV][src]);
  }
  for (int i = gtid; i < 4 * 256 * 128; i += gsz) {
    const int c = i & 127, s = (i >> 7) & 255, b = i >> 15;
    const size_t src = ((size_t)(b * 4 + l) * 256 + s) * 128 + c;
    p.KC_lat()[((size_t)b * SLAT + s) * 128 + c] = f2bf(p.in[I_CCK][src]);
    p.VTC_lat()[((size_t)b * 128 + c) * SLAT + s] = f2bf(p.in[I_CCV][src]);
  }
}

__device__ __forceinline__ void conv_tile(const float* __restrict__ src, int N, bf16_t* __restrict__ dst, int K, int k0, int n0, int mode, float* tile) {
  const int tid = opaque_tid() & 255;
  {
    const int c4 = (tid & 15) * 4, kk = tid >> 4;
    f32x4 v[4];
#pragma unroll
    for (int i = 0; i < 4; ++i) v[i] = *(const f32x4*)(src + (size_t)(k0 + kk + 16 * i) * N + n0 + c4);
#pragma unroll
    for (int i = 0; i < 4; ++i) { float* tp = tile + (kk + 16 * i) * 65 + c4; tp[0] = v[i][0]; tp[1] = v[i][1]; tp[2] = v[i][2]; tp[3] = v[i][3]; }
  }
  __syncthreads();
#pragma unroll
  for (int it = 0; it < 2; ++it) {
    const int nn = (tid >> 3) + 32 * it, kc = tid & 7;
    float v[8];
#pragma unroll
    for (int j = 0; j < 8; ++j) v[j] = tile[(kc * 8 + j) * 65 + nn];
    const int f = n0 + nn;
    int r = f;
    if (mode == 1 || mode == 2) r = (f >> 7) * 256 + (f & 127) + (mode == 2 ? 128 : 0);
    else if (mode == 3) r = (f & ~255) + 128 * ((f >> 5) & 1) + 32 * ((f >> 6) & 3) + (f & 31);
    uint4 u; u.x = pk2(v[0], v[1]); u.y = pk2(v[2], v[3]); u.z = pk2(v[4], v[5]); u.w = pk2(v[6], v[7]);
    *(uint4*)(dst + (size_t)r * K + k0 + kc * 8) = u;
  }
  __syncthreads();
}

__device__ __forceinline__ void phase0(const Params& p, char* smem) {
  const int tid = opaque_tid();
  float* tile = (float*)smem + (tid >> 8) * (64 * 65 + 32);
  const int per_layer = 6848;
  for (int tp = blockIdx.x; tp < 2 * per_layer; tp += gridDim.x) {
    const int t = 2 * tp + (tid >> 8);
    const int l = t / per_layer; int r = t - l * per_layer;
    if (r < 2816) {
      const int j = r / 704, q = r - j * 704, s = j >> 1, isup = j & 1;
      const int kt = q / 44, nt = q - kt * 44;
      const float* src = p.in[isup ? I_FU : I_FG] + (size_t)(l * 2 + s) * 1024 * DFF;
      conv_tile(src, DFF, p.WGU() + (size_t)(l * 2 + s) * 5632 * 1024, 1024, kt * 64, nt * 64, isup ? 2 : 1, tile);
    } else if (r < 4224) {
      r -= 2816; const int s = r / 704, q = r - s * 704; const int kt = q >> 4, nt = q & 15;
      conv_tile(p.in[I_FD] + (size_t)(l * 2 + s) * DFF * 1024, 1024, p.WD() + (size_t)(l * 2 + s) * 1024 * DFF, DFF, kt * 64, nt * 64, 0, tile);
    } else if (r < 6208) {
      r -= 4224; const int kt = r / 124, nt = r - kt * 124;
      conv_tile(p.in[I_WIN] + (size_t)l * 1024 * DIN, DIN, p.WIN() + (size_t)l * DIN * 1024, 1024, kt * 64, nt * 64, 3, tile);
    } else if (r < 6592) {
      r -= 6208; const int br = r >> 7, q = r & 127; const int kt = q >> 4, nt = q & 15;
      const float* src = p.in[I_WBA + br] + (size_t)l * 512 * 1024;
      conv_tile(src, 1024, p.WBR() + (size_t)(l * 3 + br) * 1024 * 512, 512, kt * 64, nt * 64, 0, tile);
    } else {
      r -= 6592; const int kt = r >> 4, nt = r & 15;
      conv_tile(p.in[I_WOUT] + (size_t)l * 1024 * 1024, 1024, p.WOUT() + (size_t)l * 1024 * 1024, 1024, kt * 64, nt * 64, 0, tile);
    }
  }
  {
    float* SC = (float*)smem;
    float* RED = SC + 5 * 1024;
    bool have = false;
    for (int it = blockIdx.x; it < 576; it += gridDim.x) {
      if (!have) {
        __syncthreads();
        for (int i = tid; i < 5 * 1024; i += NTHR) { const float cv = i < 1024 ? p.in[I_CCTX][i] : p.in[I_C][i - 1024]; SC[i] = siluf_(cv); }
        __syncthreads();
        have = true;
      }
      const int l = it / 144, cb = it - l * 144;
      const int lane = tid & 63, w = tid >> 6;
      const int col = cb * 64 + lane;
      const float* wp = p.in[I_ADAW] + ((size_t)l * 1024 + w * 128) * 9216 + col;
      float a0 = 0, a1 = 0, a2 = 0, a3 = 0, a4 = 0;
#pragma unroll 8
      for (int d = 0; d < 128; ++d) {
        const float wv = wp[(size_t)d * 9216]; const int dd = w * 128 + d;
        a0 += SC[dd] * wv; a1 += SC[1024 + dd] * wv; a2 += SC[2048 + dd] * wv; a3 += SC[3072 + dd] * wv; a4 += SC[4096 + dd] * wv;
      }
      RED[(w * 5 + 0) * 64 + lane] = a0; RED[(w * 5 + 1) * 64 + lane] = a1; RED[(w * 5 + 2) * 64 + lane] = a2; RED[(w * 5 + 3) * 64 + lane] = a3; RED[(w * 5 + 4) * 64 + lane] = a4;
      __syncthreads();
      for (int i = tid; i < 320; i += NTHR) {
        const int ci = i >> 6, cl = i & 63;
        float s = 0.f;
#pragma unroll
        for (int ww = 0; ww < 8; ++ww) s += RED[(ww * 5 + ci) * 64 + cl];
        p.MOD()[(size_t)(l * 5 + ci) * 9216 + cb * 64 + cl] = s + p.in[I_ADAB][l * 9216 + cb * 64 + cl];
      }
      __syncthreads();
    }
  }
  const int gtid = blockIdx.x * NTHR + tid, gsz = gridDim.x * NTHR;
  for (int i = gtid; i < 2 * 512; i += gsz) {
    const int d = i >> 9, c = i & 511;
    float r[4], mx = -1e30f;
    for (int j = 0; j < 4; ++j) { r[j] = p.in[I_HLB][(d * 4 + j) * 512 + c]; mx = fmaxf(mx, r[j]); }
    float s = 0; for (int j = 0; j < 4; ++j) { r[j] = expf(r[j] - mx); s += r[j]; }
    float cs = 0;
    for (int j = 0; j < 4; ++j) { if (j > 0) cs += r[j] / s; p.LB()[(d * 4 + j) * 512 + c] = (j == 0) ? 0.f : cs; }
  }
  for (int i = gtid; i < 64 * 16; i += gsz) {
    const int pos = i >> 4, j = i & 15;
    const float fr = powf(10000.f, -(float)j / 16.f);
    const float ang = (float)pos * fr;
    p.ROPE_COS()[i] = cosf(ang); p.ROPE_SIN()[i] = sinf(ang);
  }
  if (gtid < 4) {
    const int l = gtid; const float* lp = p.in[I_DLAM] + l * 256;
    float s1 = 0, s2 = 0;
    for (int j = 0; j < 64; ++j) { s1 += lp[j] * lp[64 + j]; s2 += lp[128 + j] * lp[192 + j]; }
    p.LAM()[l] = expf(s1) - expf(s2) + (0.8f - 0.6f * expf(-0.3f * (float)l));
    p.CTR()[l] = 0u;
  }
}

template <int KW, int DV, bool ISA>
__device__ __forceinline__ void attn_item(const Params& p, int l, const bf16_t* __restrict__ Qw, const bf16_t* __restrict__ Kt, int kpitch, int kwoff,
                          const bf16_t* __restrict__ VT, int S, bf16_t* __restrict__ outp, char* smem) {
  const int tid = opaque_tid(), lane = tid & 63, w = tid >> 6, l31 = lane & 31, hf = lane >> 5;
  constexpr int KP = KW + 8, NV = DV / 32, NKC = KW / 64, NVC = DV / 64;
  bf16_t* Ks = (bf16_t*)smem;
  bf16_t* Vs = Ks + 2 * 64 * KP;
  f32x16 o[NV];
#pragma unroll
  for (int vb = 0; vb < NV; ++vb)
#pragma unroll
    for (int i = 0; i < 16; ++i) o[vb][i] = 0.f;
  float m = -1e30f, lsum = 0.f;
  bf16x8 qf[4];
#pragma unroll
  for (int ks = 0; ks < 4; ++ks) qf[ks] = *(const bf16x8*)(Qw + (size_t)l31 * 512 + ks * 16 + hf * 8);
  const float C = 0.125f * 1.4426950408889634f;
  const int nk = S >> 6;
  u32x4 rk[NKC], rv[NVC];
#define AT_GLOAD(KT_) { \
    _Pragma("unroll") for (int i = 0; i < NKC; ++i) { const int c = tid + NTHR * i; const int key = c / (KW / 8), cc = c % (KW / 8); rk[i] = *(const u32x4*)(Kt + (size_t)((KT_) * 64 + key) * kpitch + cc * 8); } \
    _Pragma("unroll") for (int i = 0; i < NVC; ++i) { const int c = tid + NTHR * i; const int v = c >> 3, cc = c & 7; rv[i] = *(const u32x4*)(VT + (size_t)v * S + (KT_) * 64 + cc * 8); } }
#define AT_SWRITE(BUF_) { \
    _Pragma("unroll") for (int i = 0; i < NKC; ++i) { const int c = tid + NTHR * i; const int key = c / (KW / 8), cc = c % (KW / 8); *(u32x4*)(Ks + (BUF_) * 64 * KP + key * KP + cc * 8) = rk[i]; } \
    _Pragma("unroll") for (int i = 0; i < NVC; ++i) { const int c = tid + NTHR * i; const int v = c >> 3, cc = c & 7; \
      bf16_t* vd = Vs + (BUF_) * DV * 72 + v * 72 + (cc >> 1) * 16 + (cc & 1) * 4; \
      u32x2 lo_, hi_; lo_.x = rv[i].x; lo_.y = rv[i].y; hi_.x = rv[i].z; hi_.y = rv[i].w; *(u32x2*)vd = lo_; *(u32x2*)(vd + 8) = hi_; } }
  AT_GLOAD(0)
  AT_SWRITE(0)
  AT_GLOAD(1)
  __syncthreads();
  for (int kt = 0; kt < nk; ++kt) {
    const int buf = kt & 1;
    if (kt + 1 < nk) AT_SWRITE(buf ^ 1)
    if (kt + 2 < nk) AT_GLOAD(kt + 2)
    const bf16_t* Kb = Ks + buf * 64 * KP;
    const bf16_t* Vb = Vs + buf * DV * 72;
    f32x16 st[2];
    __builtin_amdgcn_s_setprio(1);
#pragma unroll
    for (int kb = 0; kb < 2; ++kb) {
#pragma unroll
      for (int i = 0; i < 16; ++i) st[kb][i] = 0.f;
#pragma unroll
      for (int ks = 0; ks < 4; ++ks) {
        bf16x8 kf = *(const bf16x8*)(Kb + (kb * 32 + l31) * KP + kwoff + ks * 16 + hf * 8);
        st[kb] = mfma32(kf, qf[ks], st[kb]);
      }
    }
    __builtin_amdgcn_s_setprio(0);
    float mx = st[0][0];
#pragma unroll
    for (int i = 0; i < 16; ++i) { mx = fmaxf(mx, st[0][i]); mx = fmaxf(mx, st[1][i]); }
    mx = fmaxf(mx, __shfl_xor(mx, 32));
    const float sc = mx * C;
    if (__builtin_amdgcn_ballot_w64(sc > m + 8.f) != 0ull) {
      const float mnew = fmaxf(m, sc);
      const float alpha = __builtin_amdgcn_exp2f(m - mnew);
      m = mnew; lsum *= alpha;
#pragma unroll
      for (int vb = 0; vb < NV; ++vb)
#pragma unroll
        for (int i = 0; i < 16; ++i) o[vb][i] *= alpha;
    }
    float ps = 0.f;
#pragma unroll
    for (int kb = 0; kb < 2; ++kb)
#pragma unroll
      for (int i = 0; i < 16; ++i) { const float pv = __builtin_amdgcn_exp2f(st[kb][i] * C - m); st[kb][i] = pv; ps += pv; }
    lsum += ps;
    bf16x8 pb[4];
#pragma unroll
    for (int j = 0; j < 4; ++j) {
      const int kb = j >> 1, base = (j & 1) * 8;
      u32x4 u; u.x = pk2(st[kb][base], st[kb][base + 1]); u.y = pk2(st[kb][base + 2], st[kb][base + 3]);
      u.z = pk2(st[kb][base + 4], st[kb][base + 5]); u.w = pk2(st[kb][base + 6], st[kb][base + 7]);
      pb[j] = __builtin_bit_cast(bf16x8, u);
    }
    __builtin_amdgcn_s_setprio(1);
#pragma unroll
    for (int vb = 0; vb < NV; ++vb)
#pragma unroll
      for (int j = 0; j < 4; ++j) {
        const bf16x8 vf = *(const bf16x8*)(Vb + (vb * 32 + l31) * 72 + j * 16 + 8 * hf);
        o[vb] = mfma32(vf, pb[j], o[vb]);
      }
    __builtin_amdgcn_s_setprio(0);
    __syncthreads();
  }
#undef AT_GLOAD
#undef AT_SWRITE
  const float lt = lsum + __shfl_xor(lsum, 32);
  const float inv = 1.f / lt;
  if (!ISA) {
#pragma unroll
    for (int vb = 0; vb < NV; ++vb)
#pragma unroll
      for (int g = 0; g < 4; ++g)
        store_bf4(outp + (size_t)l31 * 512 + vb * 32 + 8 * g + 4 * hf, o[vb][4 * g] * inv, o[vb][4 * g + 1] * inv, o[vb][4 * g + 2] * inv, o[vb][4 * g + 3] * inv);
  } else {
    __syncthreads();
    float* XS = (float*)smem;
    const int comp = w >> 2;
    const float lam = p.LAM()[l];
    if (comp == 1) {
      const float sc = inv * lam;
#pragma unroll
      for (int vb = 0; vb < NV; ++vb)
#pragma unroll
        for (int i = 0; i < 16; ++i) XS[((w & 3) * 64 + vb * 16 + i) * 64 + lane] = o[vb][i] * sc;
    }
    __syncthreads();
    if (comp == 0) {
      float ss = 0.f;
#pragma unroll
      for (int vb = 0; vb < NV; ++vb)
#pragma unroll
        for (int i = 0; i < 16; ++i) { const float v = o[vb][i] * inv - XS[((w & 3) * 64 + vb * 16 + i) * 64 + lane]; o[vb][i] = v; ss += v * v; }
      ss += __shfl_xor(ss, 32);
      const float lam_init = 0.8f - 0.6f * expf(-0.3f * (float)l);
      const float r = rsqrtf(ss * (1.f / 128.f) + EPSV) * (1.f - lam_init);
      const float* sw = p.in[I_SUBLN] + l * 128;
#pragma unroll
      for (int vb = 0; vb < NV; ++vb)
#pragma unroll
        for (int g = 0; g < 4; ++g) {
          f32x4 w4 = *(const f32x4*)(sw + vb * 32 + 8 * g + 4 * hf);
          store_bf4(outp + (size_t)l31 * 512 + vb * 32 + 8 * g + 4 * hf, o[vb][4 * g] * r * w4[0], o[vb][4 * g + 1] * r * w4[1], o[vb][4 * g + 2] * r * w4[2], o[vb][4 * g + 3] * r * w4[3]);
        }
    }
  }
}

__device__ __forceinline__ void hgrn_item(const Params& p, int l, bool lat, int b, int h, int dir, char* smem) {
  const int tid = opaque_tid(), lane = tid & 63, w = tid >> 6, l31 = lane & 31, hf = lane >> 5;
  bf16_t* QI = (bf16_t*)smem;
  bf16_t* QD = QI + 64 * 136;
  bf16_t* KD = QD + 64 * 136;
  bf16_t* QO = KD + 64 * 136;
  bf16_t* KO = QO + 32 * 136;
  bf16_t* KET = KO + 32 * 136;
  bf16_t* VTs = KET + 128 * 72;
  bf16_t* STs = VTs + 128 * 72;
  float* TOT = (float*)(STs + 128 * 136);
  float* BEND = TOT + 16 * 128;
  bf16_t* PP = (bf16_t*)(BEND + 128);
  const int T = lat ? 2048 : 256, nc = T >> 6;
  const int tok0 = lat ? NPR + b * 2048 : b * 256;
  const bf16_t* KK = dir ? p.KKB() : p.KKF();
  const float* LOGF = dir ? p.LOGFB() : p.LOGFF();
  float* OD = dir ? p.OB() : p.OF();
  const int vb = w & 3, kp = w >> 2, tbk = w >> 2;
  const int tg = tid >> 5, kc = tid & 31;
  const size_t colo = (size_t)h * 128 + 4 * kc;
  f32x16 sacc[2];
  if (lat) {
    const float* s0 = p.in[I_ST] + ((size_t)((b * 4 + l) * 2 + dir) * 4 + h) * 16384;
#pragma unroll
    for (int q = 0; q < 2; ++q) {
      const int k = (2 * kp + q) * 32 + l31;
#pragma unroll
      for (int g = 0; g < 4; ++g) {
        f32x4 v4 = *(const f32x4*)(s0 + (size_t)k * 128 + vb * 32 + 8 * g + 4 * hf);
        sacc[q][4 * g] = v4[0]; sacc[q][4 * g + 1] = v4[1]; sacc[q][4 * g + 2] = v4[2]; sacc[q][4 * g + 3] = v4[3];
      }
    }
  } else {
#pragma unroll
    for (int q = 0; q < 2; ++q)
#pragma unroll
      for (int i = 0; i < 16; ++i) sacc[q][i] = 0.f;
  }
  f32x4 lf0, lf1, lf2, lf3; u32x2 rq0, rq1, rq2, rq3, rk0, rk1, rk2, rk3, rv0, rv1, rv2, rv3;
#define HG_OFF(cc, i) ((size_t)(tok0 + (dir ? T - 1 - ((cc) * 64 + 4 * tg + (i)) : (cc) * 64 + 4 * tg + (i))) * 512 + colo)
#define HG_LOAD(cc) { \
    const size_t o0 = HG_OFF(cc, 0), o1 = HG_OFF(cc, 1), o2 = HG_OFF(cc, 2), o3 = HG_OFF(cc, 3); \
    lf0 = *(const f32x4*)(LOGF + o0); lf1 = *(const f32x4*)(LOGF + o1); lf2 = *(const f32x4*)(LOGF + o2); lf3 = *(const f32x4*)(LOGF + o3); \
    rq0 = *(const u32x2*)(p.BQ() + o0); rq1 = *(const u32x2*)(p.BQ() + o1); rq2 = *(const u32x2*)(p.BQ() + o2); rq3 = *(const u32x2*)(p.BQ() + o3); \
    rk0 = *(const u32x2*)(KK + o0); rk1 = *(const u32x2*)(KK + o1); rk2 = *(const u32x2*)(KK + o2); rk3 = *(const u32x2*)(KK + o3); \
    rv0 = *(const u32x2*)(p.BI() + o0); rv1 = *(const u32x2*)(p.BI() + o1); rv2 = *(const u32x2*)(p.BI() + o2); rv3 = *(const u32x2*)(p.BI() + o3); }
  if (w == 3) {
#pragma unroll
    for (int g = 0; g < 4; ++g) store_bf4(PP + l31 * 72 + 32 + 8 * g + 4 * hf, 0.f, 0.f, 0.f, 0.f);
  }
  HG_LOAD(0)
  for (int c = 0; c < nc; ++c) {
    const f32x4 c0 = lf0, c1 = c0 + lf1, c2 = c1 + lf2, c3 = c2 + lf3;
    *(f32x4*)(TOT + tg * 128 + 4 * kc) = c3;
    __syncthreads();
    {
      f32x4 run = {0.f, 0.f, 0.f, 0.f}, pre = run, r15 = run, r31 = run, r47 = run, r63;
#pragma unroll 1
      for (int gq = 0; gq < 4; ++gq) {
#pragma unroll
        for (int gi = 0; gi < 4; ++gi) {
          const int g = gq * 4 + gi;
          const f32x4 tv = *(const f32x4*)(TOT + g * 128 + 4 * kc);
          if (g < tg) pre += tv;
          run += tv;
        }
        if (gq == 0) r15 = run;
        if (gq == 1) r31 = run;
        if (gq == 2) r47 = run;
      }
      r63 = run;
      const bool lo = __builtin_amdgcn_readfirstlane(tid >> 6) < 4;
      const f32x4 refd = lo ? r15 : r47;
      f32x4 e_ref, e_end, e_off;
#pragma unroll
      for (int ch = 0; ch < 4; ++ch) {
        e_ref[ch] = __expf(refd[ch]); e_end[ch] = __expf(r63[ch] - refd[ch]);
        e_off[ch] = __expf(lo ? r31[ch] - r15[ch] : r47[ch] - r31[ch]);
      }
      if (tg == 0) { f32x4 be; be[0] = __expf(r63[0]); be[1] = __expf(r63[1]); be[2] = __expf(r63[2]); be[3] = __expf(r63[3]); *(f32x4*)(BEND + 4 * kc) = be; }
      float ket[4][4];
#define HG_ELEM(i, ci, rq, rk) { \
      const f32x4 bt = pre + ci; \
      const float qv[4] = {__uint_as_float(rq.x << 16), __uint_as_float(rq.x & 0xffff0000u), __uint_as_float(rq.y << 16), __uint_as_float(rq.y & 0xffff0000u)}; \
      const float kv[4] = {__uint_as_float(rk.x << 16), __uint_as_float(rk.x & 0xffff0000u), __uint_as_float(rk.y << 16), __uint_as_float(rk.y & 0xffff0000u)}; \
      float qd[4], kd[4], qi[4], xo[4]; \
      _Pragma("unroll") for (int ch = 0; ch < 4; ++ch) { \
        const float d = bt[ch] - refd[ch]; \
        const float E1 = __expf(fminf(d, 80.f)), E2 = __expf(fminf(-d, 80.f)); \
        qd[ch] = qv[ch] * E1; kd[ch] = kv[ch] * E2; qi[ch] = qd[ch] * e_ref[ch]; ket[ch][i] = kd[ch] * e_end[ch]; \
        xo[ch] = (lo ? kd[ch] : qd[ch]) * e_off[ch]; } \
      const int t = 4 * tg + (i); \
      store_bf4(QI + t * 136 + 4 * kc, qi[0], qi[1], qi[2], qi[3]); \
      store_bf4(QD + t * 136 + 4 * kc, qd[0], qd[1], qd[2], qd[3]); \
      store_bf4(KD + t * 136 + 4 * kc, kd[0], kd[1], kd[2], kd[3]); \
      store_bf4((lo ? KO + t * 136 : QO + (t - 32) * 136) + 4 * kc, xo[0], xo[1], xo[2], xo[3]); }
      __builtin_amdgcn_sched_barrier(0);
      HG_ELEM(0, c0, rq0, rk0)
      __builtin_amdgcn_sched_barrier(0);
      HG_ELEM(1, c1, rq1, rk1)
      __builtin_amdgcn_sched_barrier(0);
      HG_ELEM(2, c2, rq2, rk2)
      __builtin_amdgcn_sched_barrier(0);
      HG_ELEM(3, c3, rq3, rk3)
      __builtin_amdgcn_sched_barrier(0);
#pragma unroll
      for (int ch = 0; ch < 4; ++ch) store_bf4(KET + (4 * kc + ch) * 72 + 4 * tg, ket[ch][0], ket[ch][1], ket[ch][2], ket[ch][3]);
      {
        u32x2 o;
        o.x = (rv0.x & 0xffffu) | (rv1.x << 16); o.y = (rv2.x & 0xffffu) | (rv3.x << 16); *(u32x2*)(VTs + (4 * kc + 0) * 72 + 4 * tg) = o;
        o.x = (rv0.x >> 16) | (rv1.x & 0xffff0000u); o.y = (rv2.x >> 16) | (rv3.x & 0xffff0000u); *(u32x2*)(VTs + (4 * kc + 1) * 72 + 4 * tg) = o;
        o.x = (rv0.y & 0xffffu) | (rv1.y << 16); o.y = (rv2.y & 0xffffu) | (rv3.y << 16); *(u32x2*)(VTs + (4 * kc + 2) * 72 + 4 * tg) = o;
        o.x = (rv0.y >> 16) | (rv1.y & 0xffff0000u); o.y = (rv2.y >> 16) | (rv3.y & 0xffff0000u); *(u32x2*)(VTs + (4 * kc + 3) * 72 + 4 * tg) = o;
      }
      if (c + 1 < nc) HG_LOAD(c + 1)
#pragma unroll
      for (int q = 0; q < 2; ++q) {
        const int k = (2 * kp + q) * 32 + l31;
#pragma unroll
        for (int i = 0; i < 16; ++i) STs[(vb * 32 + 8 * (i >> 2) + 4 * hf + (i & 3)) * 136 + k] = f2bf(sacc[q][i]);
      }
    }
    __syncthreads();
    f32x16 pacc;
#pragma unroll
    for (int i = 0; i < 16; ++i) pacc[i] = 0.f;
    if (w < 3) {
      const bf16_t* Ap = w == 0 ? KD : (w == 1 ? KD + 32 * 136 : KO);
      const bf16_t* Bp = w == 0 ? QD : (w == 1 ? QD + 32 * 136 : QO);
      bf16x8 kf[8], qf[8];
#pragma unroll
      for (int ks = 0; ks < 8; ++ks) { kf[ks] = *(const bf16x8*)(Ap + l31 * 136 + ks * 16 + hf * 8); qf[ks] = *(const bf16x8*)(Bp + l31 * 136 + ks * 16 + hf * 8); }
#pragma unroll
      for (int ks = 0; ks < 8; ++ks) pacc = mfma32(kf[ks], qf[ks], pacc);
    }
    if (w < 3) {
      const int tb = (w == 1 || w == 2) ? 1 : 0, sb = (w == 1) ? 1 : 0;
      const bool diag = w < 2;
#pragma unroll
      for (int g = 0; g < 4; ++g) {
        const int sl = 8 * g + 4 * hf;
        float v[4];
#pragma unroll
        for (int e = 0; e < 4; ++e) v[e] = (!diag || l31 >= sl + e) ? pacc[4 * g + e] : 0.f;
        store_bf4(PP + (tb * 32 + l31) * 72 + sb * 32 + sl, v[0], v[1], v[2], v[3]);
      }
    }
    __syncthreads();
    {
      f32x16 oacc;
#pragma unroll
      for (int i = 0; i < 16; ++i) oacc[i] = 0.f;
      {
        bf16x8 af[8], bfr[8];
#pragma unroll
        for (int ks = 0; ks < 8; ++ks) { af[ks] = *(const bf16x8*)(STs + (vb * 32 + l31) * 136 + ks * 16 + hf * 8); bfr[ks] = *(const bf16x8*)(QI + (tbk * 32 + l31) * 136 + ks * 16 + hf * 8); }
#pragma unroll
        for (int ks = 0; ks < 8; ++ks) oacc = mfma32(af[ks], bfr[ks], oacc);
      }
      {
        bf16x8 af[4], bfr[4];
#pragma unroll
        for (int ks = 0; ks < 4; ++ks) { af[ks] = *(const bf16x8*)(VTs + (vb * 32 + l31) * 72 + ks * 16 + hf * 8); bfr[ks] = *(const bf16x8*)(PP + (tbk * 32 + l31) * 72 + ks * 16 + hf * 8); }
        oacc = mfma32(af[0], bfr[0], oacc); oacc = mfma32(af[1], bfr[1], oacc);
        if (__builtin_amdgcn_readfirstlane(tbk) != 0) { oacc = mfma32(af[2], bfr[2], oacc); oacc = mfma32(af[3], bfr[3], oacc); }
      }
      const int j = tbk * 32 + l31;
      const int tt = dir ? T - 1 - (c * 64 + j) : c * 64 + j;
      float* od = OD + (size_t)(tok0 + tt) * 512 + h * 128 + vb * 32;
#pragma unroll
      for (int g = 0; g < 4; ++g) *(f32x4*)(od + 8 * g + 4 * hf) = (f32x4){oacc[4 * g], oacc[4 * g + 1], oacc[4 * g + 2], oacc[4 * g + 3]};
    }
    {
      bf16x8 af[4], bk[2][4];
#pragma unroll
      for (int ks = 0; ks < 4; ++ks) {
        af[ks] = *(const bf16x8*)(VTs + (vb * 32 + l31) * 72 + ks * 16 + hf * 8);
        bk[0][ks] = *(const bf16x8*)(KET + ((2 * kp) * 32 + l31) * 72 + ks * 16 + hf * 8);
        bk[1][ks] = *(const bf16x8*)(KET + ((2 * kp + 1) * 32 + l31) * 72 + ks * 16 + hf * 8);
      }
#pragma unroll
      for (int q = 0; q < 2; ++q) {
        const float dec = BEND[(2 * kp + q) * 32 + l31];
#pragma unroll
        for (int i = 0; i < 16; ++i) sacc[q][i] *= dec;
      }
#pragma unroll
      for (int ks = 0; ks < 4; ++ks) { sacc[0] = mfma32(af[ks], bk[0][ks], sacc[0]); sacc[1] = mfma32(af[ks], bk[1][ks], sacc[1]); }
    }
    __syncthreads();
  }
#undef HG_OFF
#undef HG_LOAD
#undef HG_ELEM
  if (!lat) {
    float* sd = p.out + OUT_HG + ((size_t)((b * 4 + l) * 2 + dir) * 4 + h) * 16384;
#pragma unroll
    for (int q = 0; q < 2; ++q) {
      const int k = (2 * kp + q) * 32 + l31;
#pragma unroll
      for (int g = 0; g < 4; ++g)
        *(f32x4*)(sd + (size_t)k * 128 + vb * 32 + 8 * g + 4 * hf) = (f32x4){sacc[q][4 * g], sacc[q][4 * g + 1], sacc[q][4 * g + 2], sacc[q][4 * g + 3]};
    }
  }
}

__device__ __forceinline__ void phase_mixers(const Params& p, int l, char* smem) {
  volatile int* bc = (volatile int*)(smem + SMEM_BYTES - 16);
  const int w = opaque_tid() >> 6;
#ifdef STATIC_SCHED
  for (int it = blockIdx.x; it < 928; it += gridDim.x) {
    __syncthreads();
    int idx = it;
#else
  for (;;) {
    __syncthreads();
    if (opaque_tid() == 0) *bc = (int)atomicAdd(p.CTR() + l, 1u);
    __syncthreads();
    int idx = *bc;
    if (idx >= 928) break;
#endif
    if (idx < 160) {
      const bool lat = idx < 32;
      if (!lat) idx -= 32;
      hgrn_item(p, l, lat, idx >> 3, (idx >> 1) & 3, idx & 1, smem);
    } else if (idx < 416 || (idx >= 672 && idx < 800)) {
      const bool lat = idx < 416;
      int b, h, qt;
      if (lat) { idx -= 160; b = idx >> 6; h = (idx >> 4) & 3; qt = idx & 15; } else { idx -= 672; b = idx >> 3; h = (idx >> 1) & 3; qt = idx & 1; }
      const int S = lat ? SLAT : 256;
      const int row = (lat ? NPR + b * 2048 : b * 256) + qt * 128 + 32 * (w & 3), comp = w >> 2;
      const bf16_t* Kb = lat ? p.KA_lat() : p.KA_ctx();
      const bf16_t* Vb = lat ? p.VTA_lat() : p.VTA_ctx();
      attn_item<128, 128, true>(p, l, p.QA() + (size_t)row * 512 + h * 128 + comp * 64, Kb + (size_t)b * S * 512 + h * 128, 512, comp * 64,
                                Vb + ((size_t)b * 512 + h * 128) * S, S, p.OA() + (size_t)row * 512 + h * 128, smem);
    } else {
      const bool lat = idx < 672;
      int b, kvh, qt;
      if (lat) { idx -= 416; b = idx >> 6; kvh = (idx >> 5) & 1; qt = idx & 31; } else { idx -= 800; b = idx >> 3; kvh = (idx >> 2) & 1; qt = idx & 3; }
      const int S = lat ? SLAT : 256;
      const int row = (lat ? NPR + b * 2048 : b * 256) + qt * 64 + 32 * (w >> 2), hq = kvh * 4 + (w & 3);
      const bf16_t* Kb = lat ? p.KC_lat() : p.KC_ctx();
      const bf16_t* Vb = lat ? p.VTC_lat() : p.VTC_ctx();
      attn_item<64, 64, false>(p, l, p.QC() + (size_t)row * 512 + hq * 64, Kb + (size_t)b * S * 128 + kvh * 64, 128, 0,
                               Vb + ((size_t)b * 128 + kvh * 64) * S, S, p.OC() + (size_t)row * 512 + hq * 64, smem);
    }
  }
}

__device__ __forceinline__ void phase_gnorm(const Params& p, int l) {
  const int lane = opaque_tid() & 63, w = opaque_tid() >> 6;
  const float* gw = p.in[I_GNORM] + l * 128;
  for (int grp = blockIdx.x; grp < NT / 8; grp += gridDim.x) {
    const int row = grp * 8 + w;
    const size_t off = (size_t)row * 512 + lane * 8;
    f32x4 a0 = *(const f32x4*)(p.OF() + off), a1 = *(const f32x4*)(p.OF() + off + 4);
    f32x4 b0 = *(const f32x4*)(p.OB() + off), b1 = *(const f32x4*)(p.OB() + off + 4);
    float v[8]; float ss = 0.f;
#pragma unroll
    for (int e = 0; e < 4; ++e) { v[e] = a0[e] + b0[e]; v[4 + e] = a1[e] + b1[e]; }
#pragma unroll
    for (int e = 0; e < 8; ++e) ss += v[e] * v[e];
    ss += __shfl_xor(ss, 8); ss += __shfl_xor(ss, 4); ss += __shfl_xor(ss, 2); ss += __shfl_xor(ss, 1);
    const float r = rsqrtf(ss * (1.f / 128.f) + EPSV);
    const int vc = (lane & 15) * 8;
    uint4 g = *(const uint4*)(p.BG() + off);
    float bg[8] = {__uint_as_float(g.x << 16), __uint_as_float(g.x & 0xffff0000u), __uint_as_float(g.y << 16), __uint_as_float(g.y & 0xffff0000u),
                   __uint_as_float(g.z << 16), __uint_as_float(g.z & 0xffff0000u), __uint_as_float(g.w << 16), __uint_as_float(g.w & 0xffff0000u)};
    float o[8];
#pragma unroll
    for (int e = 0; e < 8; ++e) o[e] = v[e] * r * gw[vc + e] * bg[e];
    uint4 u; u.x = pk2(o[0], o[1]); u.y = pk2(o[2], o[3]); u.z = pk2(o[4], o[5]); u.w = pk2(o[6], o[7]);
    *(uint4*)(p.OBR() + off) = u;
  }
}

#define XB_TMO      128
#define XB_XCNT(j)  (256  + 64 * (j))
#define XB_XSUB(j)  (1280 + 64 * (j))
#define XB_XGEN(j)  (2304 + 64 * (j))
#define XB_TOP      3328
#define XB_TOPGEN   3392
#define XCD_BAR_WORDS 3456
#define XB_SPIN_CAP (1u << 18)
#define LAS __attribute__((address_space(3)))

__device__ __forceinline__ unsigned xb_ld(unsigned* p)              { return __hip_atomic_load(p, __ATOMIC_RELAXED, __HIP_MEMORY_SCOPE_AGENT); }
__device__ __forceinline__ unsigned xb_add(unsigned* p, unsigned v) { return __hip_atomic_fetch_add(p, v, __ATOMIC_RELAXED, __HIP_MEMORY_SCOPE_AGENT); }
__device__ __forceinline__ unsigned xb_xcc_id() { return (unsigned)__builtin_amdgcn_s_getreg((3 << 11) | 20) & 0xFu; }
#define XB_SPIN(cond, bar) do { unsigned _sp = 0; while (cond) { __builtin_amdgcn_s_sleep(1); \
    if ((++_sp & 255u) == 0u) { if (xb_ld(&(bar)[XB_TMO])) break; if (_sp > XB_SPIN_CAP) { atomicAdd(&(bar)[XB_TMO], 1u); break; } } } } while (0)

struct XcdBarrier {
    unsigned* bar; unsigned x;
    volatile LAS unsigned* st;
};

__device__ __forceinline__ XcdBarrier xcd_barrier_post(unsigned* bar, volatile LAS unsigned* st) {
    XcdBarrier b; b.bar = bar; b.x = xb_xcc_id(); b.st = st;
    if (threadIdx.x == 0) (void)xb_add(&bar[XB_XCNT(b.x)], 1u);
    return b;
}
__device__ __forceinline__ void xcd_barrier_complete(unsigned* bar, unsigned x, unsigned& nloc, unsigned& nx) {
    const unsigned G = gridDim.x * gridDim.y * gridDim.z;
    unsigned sum, cnt, mine, sp = 0u;
    for (;;) {
        sum = 0u; cnt = 0u; mine = 0u;
#pragma unroll
        for (unsigned j = 0; j < 16; ++j) { const unsigned c = xb_ld(&bar[XB_XCNT(j)]); sum += c; cnt += (c > 0u) ? 1u : 0u; mine = (j == x) ? c : mine; }
        if (sum == G) break;
        __builtin_amdgcn_s_sleep(1);
        if ((++sp & 255u) == 0u) { if (xb_ld(&bar[XB_TMO])) break; if (sp > XB_SPIN_CAP) { atomicAdd(&bar[XB_TMO], 1u); break; } }
    }
    nloc = mine > 0u ? mine : 1u; nx = cnt > 0u ? cnt : 1u;
}

__device__ __forceinline__ void xcd_barrier(const XcdBarrier& b) {
    asm volatile("s_waitcnt vmcnt(0)" ::: "memory");
    __syncthreads();
    if (threadIdx.x == 0) {
        unsigned* bar = b.bar;
        __builtin_amdgcn_s_waitcnt(0);
        unsigned nloc = b.st[0], nx = b.st[1];
        if (nloc == 0u) { xcd_barrier_complete(bar, b.x, nloc, nx); b.st[0] = nloc; b.st[1] = nx; }
        const unsigned old = xb_add(&bar[XB_XSUB(b.x)], 1u);
        const unsigned gen = old / nloc;
        if (old + 1u == (gen + 1u) * nloc) {
            __builtin_amdgcn_fence(__ATOMIC_RELEASE, "agent");
            asm volatile("s_waitcnt vmcnt(0)" ::: "memory");
            const unsigned og = xb_add(&bar[XB_TOP], 1u);
            const unsigned tg = og / nx;
            if (og + 1u == (tg + 1u) * nx) xb_add(&bar[XB_TOPGEN], 1u);
            else XB_SPIN(xb_ld(&bar[XB_TOPGEN]) == tg, bar);
            __builtin_amdgcn_fence(__ATOMIC_ACQUIRE, "agent");
            xb_add(&bar[XB_XGEN(b.x)], 1u);
            asm volatile("s_waitcnt vmcnt(0)" ::: "memory");
        } else {
            XB_SPIN(xb_ld(&bar[XB_XGEN(b.x)]) == gen, bar);
            __builtin_amdgcn_fence(__ATOMIC_ACQUIRE, "agent");
            asm volatile("s_waitcnt vmcnt(0)" ::: "memory");
        }
    }
    __syncthreads();
}


#ifndef DBG_STOP
#define DBG_STOP 1000
#endif
#define STOP_AT(n) if (DBG_STOP == (n)) return;
#ifndef REP_GEMM
#define REP_GEMM 1
#endif
__global__ void __launch_bounds__(512, 2) fwd_megakernel(Params p) {
  extern __shared__ __attribute__((aligned(16))) char smem[];
  cg::grid_group grid = cg::this_grid();
  PG8_LAS unsigned char* lds = (PG8_LAS unsigned char*)smem;
  volatile LAS unsigned* xst = (volatile LAS unsigned*)(lds + SMEM_BYTES - 32);
  if (threadIdx.x == 0) { xst[0] = 0u; xst[1] = 0u; }
  __syncthreads();
  const XcdBarrier xbar = xcd_barrier_post(p.BAR(), xst);
  phase0(p, smem);
  grid.sync();
  phase_rowwise(p, true, -1, 0, 0.f, 0, 0, 0, 0, 1);
  xcd_barrier(xbar);
#pragma unroll 1
  for (int l = 0; l < 4; ++l) {
    for (int rep_ = 0; rep_ < REP_GEMM; ++rep_) { { int lq = l; asm volatile("" : "+s"(lq)); phase_gemm_gu2(p, lq, 0, lds); } }
    xcd_barrier(xbar);
    for (int rep_ = 0; rep_ < REP_GEMM; ++rep_) { { int lq = l; asm volatile("" : "+s"(lq)); phase_gemm_y2(p, p.ACT(), DFF, p.WD() + (size_t)(lq * 2 + 0) * 1024 * DFF, lds); } }
    xcd_barrier(xbar);
    { int lq = l; asm volatile("" : "+s"(lq)); phase_rowwise(p, false, lq, 0, 0.5f, 2, lq, 1, 3, 4); }
    { int lq = l; asm volatile("" : "+s"(lq)); cache_convert(p, lq); }
    xcd_barrier(xbar);
    STOP_AT(1)
    for (int rep_ = 0; rep_ < REP_GEMM; ++rep_) { { int lq = l; asm volatile("" : "+s"(lq)); phase_gemm_win2(p, lq, lds); } }
    xcd_barrier(xbar);
    STOP_AT(2)
    { int lq = l; asm volatile("" : "+s"(lq)); phase_mixers(p, lq, smem); }
    xcd_barrier(xbar);
    STOP_AT(3)
#if DBG_STOP == 6 || DBG_STOP == 7 || DBG_STOP == 8
    {
      const size_t gt = (size_t)blockIdx.x * 256 + opaque_tid(), gs = (size_t)gridDim.x * 256;
      for (size_t i = gt; i < (size_t)NT * 512; i += gs) {
#if DBG_STOP == 6 || DBG_STOP == 7
        p.out[i] = bf2f(p.OA()[i]);
        p.out[(size_t)NT * 512 + i] = bf2f(p.OC()[i]);
#endif
#if DBG_STOP == 6 || DBG_STOP == 8
        p.out[OUT_AK + i] = p.OF()[i];
        p.out[OUT_AV + i] = p.OB()[i];
#endif
      }
      return;
    }
#endif
    { int lq = l; asm volatile("" : "+s"(lq)); phase_gnorm(p, lq); }
    xcd_barrier(xbar);
    for (int rep_ = 0; rep_ < REP_GEMM; ++rep_) { { int lq = l; asm volatile("" : "+s"(lq)); phase_gemm_br2(p, lq, lds); } }
    xcd_barrier(xbar);
    STOP_AT(4)
    for (int rep_ = 0; rep_ < REP_GEMM; ++rep_) { { int lq = l; asm volatile("" : "+s"(lq)); phase_gemm_y2(p, p.MERGED(), 1024, p.WOUT() + (size_t)lq * 1024 * 1024, lds); } }
    xcd_barrier(xbar);
    { int lq = l; asm volatile("" : "+s"(lq)); phase_rowwise(p, false, lq, 1, 1.0f, 5, lq, 2, 6, 7); }
    xcd_barrier(xbar);
    for (int rep_ = 0; rep_ < REP_GEMM; ++rep_) { { int lq = l; asm volatile("" : "+s"(lq)); phase_gemm_gu2(p, lq, 1, lds); } }
    xcd_barrier(xbar);
    for (int rep_ = 0; rep_ < REP_GEMM; ++rep_) { { int lq = l; asm volatile("" : "+s"(lq)); phase_gemm_y2(p, p.ACT(), DFF, p.WD() + (size_t)(lq * 2 + 1) * 1024 * DFF, lds); } }
    xcd_barrier(xbar);
    if (l < 3) { { int lq = l; asm volatile("" : "+s"(lq)); phase_rowwise(p, false, lq, 2, 0.5f, 8, lq + 1, 0, 0, 1); } xcd_barrier(xbar); }
    else { int lq = l; asm volatile("" : "+s"(lq)); phase_rowwise(p, false, lq, 2, 0.5f, 8, -1, 0, 0, 0); }
    STOP_AT(5)
  }
}

extern "C" void kernel_launch(void* const* d_in, const int* in_sizes, int n_in, void* d_out, int out_size, void* d_ws, size_t ws_size, hipStream_t stream) {
  static int grid_blocks = 0;
  if (!grid_blocks) {
    int dev = 0, cus = 0, per_cu = 0;
    hipGetDevice(&dev);
    hipDeviceGetAttribute(&cus, hipDeviceAttributeMultiprocessorCount, dev);
    hipFuncSetAttribute((const void*)fwd_megakernel, hipFuncAttributeMaxDynamicSharedMemorySize, SMEM_BYTES);
    hipOccupancyMaxActiveBlocksPerMultiprocessor(&per_cu, fwd_megakernel, NTHR, SMEM_BYTES);
    if (per_cu < 1) per_cu = 1;
    if (per_cu > 1) per_cu = 1;
    grid_blocks = cus * per_cu;
  }
  Params p{};
  for (int i = 0; i < 27; ++i) p.in[i] = (const float*)d_in[i];
  p.out = (float*)d_out;
  p.ws = (char*)d_ws;
  if (WS_TOTAL > ws_size) { fprintf(stderr, "workspace too small: need %zu have %zu\n", (size_t)WS_TOTAL, ws_size); return; }
  (void)hipMemsetAsync(p.ws + O_BAR, 0, (size_t)3456 * 4, stream);
  void* args[] = {&p};
  hipError_t e = hipLaunchCooperativeKernel((const void*)fwd_megakernel, dim3(grid_blocks), dim3(NTHR), args, SMEM_BYTES, stream);
  if (e != hipSuccess) fprintf(stderr, "cooperative launch failed: %s (grid %d)\n", hipGetErrorString(e), grid_blocks);
}
```

```cpp
#include <hip/hip_runtime.h>
#include <hip/hip_cooperative_groups.h>
#include <cstdio>
#include <cstdint>
namespace cg = cooperative_groups;

typedef unsigned short bf16_t;
typedef short bf16x8 __attribute__((ext_vector_type(8)));
typedef short bf16x4 __attribute__((ext_vector_type(4)));
typedef float f32x16 __attribute__((ext_vector_type(16)));
typedef float f32x4 __attribute__((ext_vector_type(4)));
typedef unsigned u32x4 __attribute__((ext_vector_type(4)));
typedef unsigned u32x2 __attribute__((ext_vector_type(2)));

#define NT 12288
#define NPR 4096
#define DM 1024
#define DFF 2816
#define DIN 7936
#define SLAT 2304
#define SMEM_BYTES 163840
#define NTHR 512
#define EPSV 1e-6f

#define OUT_AK 12582912
#define OUT_AV 20971520
#define OUT_HG 29360128
#define OUT_CK 37748736
#define OUT_CV 39845888

constexpr size_t al256(size_t x) { return (x + 255) & ~(size_t)255; }
constexpr size_t O_WGU = 0;
constexpr size_t O_WD = O_WGU + al256((size_t)4 * 2 * 5632 * 1024 * 2);
constexpr size_t O_WIN = O_WD + al256((size_t)4 * 2 * 1024 * DFF * 2);
constexpr size_t O_WBR = O_WIN + al256((size_t)4 * DIN * 1024 * 2);
constexpr size_t O_WOUT = O_WBR + al256((size_t)4 * 3 * 1024 * 512 * 2);
constexpr size_t O_H = O_WOUT + al256((size_t)4 * 1024 * 1024 * 2);
constexpr size_t O_ACT = O_H + al256((size_t)NT * 1024 * 2);
constexpr size_t O_Y = O_ACT + al256((size_t)NT * 3072 * 2);
constexpr size_t O_OF = O_Y + al256((size_t)NT * 1024 * 4);
constexpr size_t O_OB = O_OF + al256((size_t)NT * 512 * 4);
constexpr size_t O_QA = O_OB + al256((size_t)NT * 512 * 4);
constexpr size_t O_QC = O_QA + al256((size_t)NT * 512 * 2);
constexpr size_t O_KA_ctx = O_QC + al256((size_t)NT * 512 * 2);
constexpr size_t O_VTA_ctx = O_KA_ctx + al256((size_t)NPR * 512 * 2);
constexpr size_t O_KC_ctx = O_VTA_ctx + al256((size_t)NPR * 512 * 2);
constexpr size_t O_VTC_ctx = O_KC_ctx + al256((size_t)NPR * 128 * 2);
constexpr size_t O_KA_lat = O_VTC_ctx + al256((size_t)NPR * 128 * 2);
constexpr size_t O_VTA_lat = O_KA_lat + al256((size_t)4 * SLAT * 512 * 2);
constexpr size_t O_KC_lat = O_VTA_lat + al256((size_t)4 * SLAT * 512 * 2);
constexpr size_t O_VTC_lat = O_KC_lat + al256((size_t)4 * SLAT * 128 * 2);
constexpr size_t O_BQ = O_VTC_lat + al256((size_t)4 * SLAT * 128 * 2);
constexpr size_t O_BI = O_BQ + al256((size_t)NT * 512 * 2);
constexpr size_t O_KKF = O_BI + al256((size_t)NT * 512 * 2);
constexpr size_t O_KKB = O_KKF + al256((size_t)NT * 512 * 2);
constexpr size_t O_BG = O_KKB + al256((size_t)NT * 512 * 2);
constexpr size_t O_LOGFF = O_BG + al256((size_t)NT * 512 * 2);
constexpr size_t O_LOGFB = O_LOGFF + al256((size_t)NT * 512 * 4);
constexpr size_t O_OA = O_LOGFB + al256((size_t)NT * 512 * 4);
constexpr size_t O_OBR = O_OA + al256((size_t)NT * 512 * 2);
constexpr size_t O_OC = O_OBR + al256((size_t)NT * 512 * 2);
constexpr size_t O_MOD = O_OC + al256((size_t)NT * 512 * 2);
constexpr size_t O_LB = O_MOD + al256((size_t)4 * 5 * 9216 * 4);
constexpr size_t O_LAM = O_LB + al256((size_t)2 * 4 * 512 * 4);
constexpr size_t O_ROPE_COS = O_LAM + al256((size_t)256);
constexpr size_t O_ROPE_SIN = O_ROPE_COS + al256((size_t)64 * 16 * 4);
constexpr size_t O_CTR = O_ROPE_SIN + al256((size_t)64 * 16 * 4);
constexpr size_t O_BAR = O_CTR + al256((size_t)256);
constexpr size_t WS_TOTAL = O_BAR + al256((size_t)3456 * 4);
struct Params {
  const float* in[27];
  float* out;
  char* ws;
  __device__ __forceinline__ bf16_t* WGU() const { return (bf16_t*)(ws + O_WGU); }
  __device__ __forceinline__ bf16_t* WD() const { return (bf16_t*)(ws + O_WD); }
  __device__ __forceinline__ bf16_t* WIN() const { return (bf16_t*)(ws + O_WIN); }
  __device__ __forceinline__ bf16_t* WBR() const { return (bf16_t*)(ws + O_WBR); }
  __device__ __forceinline__ bf16_t* WOUT() const { return (bf16_t*)(ws + O_WOUT); }
  __device__ __forceinline__ bf16_t* H() const { return (bf16_t*)(ws + O_H); }
  __device__ __forceinline__ bf16_t* ACT() const { return (bf16_t*)(ws + O_ACT); }
  __device__ __forceinline__ float* Y() const { return (float*)(ws + O_Y); }
  __device__ __forceinline__ float* OF() const { return (float*)(ws + O_OF); }
  __device__ __forceinline__ float* OB() const { return (float*)(ws + O_OB); }
  __device__ __forceinline__ bf16_t* QA() const { return (bf16_t*)(ws + O_QA); }
  __device__ __forceinline__ bf16_t* QC() const { return (bf16_t*)(ws + O_QC); }
  __device__ __forceinline__ bf16_t* KA_ctx() const { return (bf16_t*)(ws + O_KA_ctx); }
  __device__ __forceinline__ bf16_t* VTA_ctx() const { return (bf16_t*)(ws + O_VTA_ctx); }
  __device__ __forceinline__ bf16_t* KC_ctx() const { return (bf16_t*)(ws + O_KC_ctx); }
  __device__ __forceinline__ bf16_t* VTC_ctx() const { return (bf16_t*)(ws + O_VTC_ctx); }
  __device__ __forceinline__ bf16_t* KA_lat() const { return (bf16_t*)(ws + O_KA_lat); }
  __device__ __forceinline__ bf16_t* VTA_lat() const { return (bf16_t*)(ws + O_VTA_lat); }
  __device__ __forceinline__ bf16_t* KC_lat() const { return (bf16_t*)(ws + O_KC_lat); }
  __device__ __forceinline__ bf16_t* VTC_lat() const { return (bf16_t*)(ws + O_VTC_lat); }
  __device__ __forceinline__ bf16_t* BQ() const { return (bf16_t*)(ws + O_BQ); }
  __device__ __forceinline__ bf16_t* BI() const { return (bf16_t*)(ws + O_BI); }
  __device__ __forceinline__ bf16_t* KKF() const { return (bf16_t*)(ws + O_KKF); }
  __device__ __forceinline__ bf16_t* KKB() const { return (bf16_t*)(ws + O_KKB); }
  __device__ __forceinline__ bf16_t* BG() const { return (bf16_t*)(ws + O_BG); }
  __device__ __forceinline__ float* LOGFF() const { return (float*)(ws + O_LOGFF); }
  __device__ __forceinline__ float* LOGFB() const { return (float*)(ws + O_LOGFB); }
  __device__ __forceinline__ bf16_t* OA() const { return (bf16_t*)(ws + O_OA); }
  __device__ __forceinline__ bf16_t* OBR() const { return (bf16_t*)(ws + O_OBR); }
  __device__ __forceinline__ bf16_t* OC() const { return (bf16_t*)(ws + O_OC); }
  __device__ __forceinline__ float* MOD() const { return (float*)(ws + O_MOD); }
  __device__ __forceinline__ float* LB() const { return (float*)(ws + O_LB); }
  __device__ __forceinline__ float* LAM() const { return (float*)(ws + O_LAM); }
  __device__ __forceinline__ float* ROPE_COS() const { return (float*)(ws + O_ROPE_COS); }
  __device__ __forceinline__ float* ROPE_SIN() const { return (float*)(ws + O_ROPE_SIN); }
  __device__ __forceinline__ unsigned* CTR() const { return (unsigned*)(ws + O_CTR); }
  __device__ __forceinline__ unsigned* BAR() const { return (unsigned*)(ws + O_BAR); }
  __device__ __forceinline__ bf16_t* GATE() const { return (bf16_t*)(ws + O_ACT); }
  __device__ __forceinline__ bf16_t* MERGED() const { return (bf16_t*)(ws + O_BQ); }
};
enum { I_XP = 0, I_XS, I_C, I_CAK, I_CAV, I_ST, I_CCK, I_CCV, I_CCTX, I_ADAW, I_ADAB, I_NPRE, I_NPOST, I_FG, I_FU, I_FD, I_WIN,
       I_DLAM, I_SUBLN, I_HLB, I_GNORM, I_QNORM, I_KNORM, I_WBA, I_WBB, I_WBC, I_WOUT };

typedef float f32x2_ __attribute__((ext_vector_type(2)));
typedef __bf16 bf16x2_ __attribute__((ext_vector_type(2)));
__device__ __forceinline__ unsigned pk2(float lo, float hi) {
  const f32x2_ v = {lo, hi};
  const bf16x2_ b = __builtin_convertvector(v, bf16x2_);
  return __builtin_bit_cast(unsigned, b);
}
__device__ __forceinline__ bf16_t f2bf(float f) { return (bf16_t)(pk2(f, 0.f) & 0xffffu); }
__device__ __forceinline__ float bf2f(bf16_t h) { return __uint_as_float(((unsigned)h) << 16); }
__device__ __forceinline__ float sigmoidf_(float x) { return __builtin_amdgcn_rcpf(1.f + __expf(-x)); }
__device__ __forceinline__ float siluf_(float x) { return x * sigmoidf_(x); }
__device__ __forceinline__ float logsigf_(float z) { return -(fmaxf(-z, 0.f) + log1pf(__expf(-fabsf(z)))); }
__device__ __forceinline__ f32x16 mfma32(bf16x8 a, bf16x8 b, f32x16 c) { return __builtin_amdgcn_mfma_f32_32x32x16_bf16(a, b, c, 0, 0, 0); }
__device__ __forceinline__ float wave_sum(float v) {
  v += __shfl_xor(v, 32); v += __shfl_xor(v, 16); v += __shfl_xor(v, 8); v += __shfl_xor(v, 4); v += __shfl_xor(v, 2); v += __shfl_xor(v, 1); return v;
}
__device__ __forceinline__ int opaque_tid() { int t = threadIdx.x; asm volatile("" : "+v"(t)); return t; }
__device__ __forceinline__ void store_bf4(bf16_t* p, float a, float b, float c, float d) { uint2 u; u.x = pk2(a, b); u.y = pk2(c, d); *(uint2*)p = u; }

__device__ __forceinline__ void gemm_kloop(const bf16_t* __restrict__ A, int lda, const bf16_t* __restrict__ Bt, int ldb, int K,
                                           f32x16 (&acc)[2][2], char* smem) {
  const int tid = opaque_tid(), lane = tid & 63, w = tid >> 6, wm = w >> 1, wn = w & 1, l31 = lane & 31, hf = lane >> 5;
  bf16_t* As = (bf16_t*)smem;
  bf16_t* Bs = As + 2 * 256 * 72;
  uint4 ra[4], rb[2];
  const int nk = K >> 6;
  const int r0 = tid >> 3, cc = (tid & 7) * 8;
  const bf16_t* ap = A + (size_t)r0 * lda + cc;
  const bf16_t* bp = Bt + (size_t)r0 * ldb + cc;
#pragma unroll
  for (int i = 0; i < 4; ++i) ra[i] = *(const uint4*)(ap + (size_t)(64 * i) * lda);
#pragma unroll
  for (int i = 0; i < 2; ++i) rb[i] = *(const uint4*)(bp + (size_t)(64 * i) * ldb);
#pragma unroll
  for (int i = 0; i < 4; ++i) *(uint4*)(As + (r0 + 64 * i) * 72 + cc) = ra[i];
#pragma unroll
  for (int i = 0; i < 2; ++i) *(uint4*)(Bs + (r0 + 64 * i) * 72 + cc) = rb[i];
  __syncthreads();
  for (int kt = 0; kt < nk; ++kt) {
    const int buf = kt & 1;
    if (kt + 1 < nk) {
#pragma unroll
      for (int i = 0; i < 4; ++i) ra[i] = *(const uint4*)(ap + (size_t)(64 * i) * lda + (kt + 1) * 64);
#pragma unroll
      for (int i = 0; i < 2; ++i) rb[i] = *(const uint4*)(bp + (size_t)(64 * i) * ldb + (kt + 1) * 64);
    }
    const bf16_t* a = As + buf * 256 * 72 + (wm * 64 + l31) * 72 + hf * 8;
    const bf16_t* b = Bs + buf * 128 * 72 + (wn * 64 + l31) * 72 + hf * 8;
#pragma unroll
    for (int ks = 0; ks < 4; ++ks) {
      bf16x8 a0 = *(const bf16x8*)(a + ks * 16), a1 = *(const bf16x8*)(a + 32 * 72 + ks * 16);
      bf16x8 b0 = *(const bf16x8*)(b + ks * 16), b1 = *(const bf16x8*)(b + 32 * 72 + ks * 16);
      acc[0][0] = mfma32(b0, a0, acc[0][0]); acc[0][1] = mfma32(b1, a0, acc[0][1]);
      acc[1][0] = mfma32(b0, a1, acc[1][0]); acc[1][1] = mfma32(b1, a1, acc[1][1]);
    }
    if (kt + 1 < nk) {
      const int nb = buf ^ 1;
#pragma unroll
      for (int i = 0; i < 4; ++i) *(uint4*)(As + nb * 256 * 72 + (r0 + 64 * i) * 72 + cc) = ra[i];
#pragma unroll
      for (int i = 0; i < 2; ++i) *(uint4*)(Bs + nb * 128 * 72 + (r0 + 64 * i) * 72 + cc) = rb[i];
    }
    __syncthreads();
  }
}

__device__ __forceinline__ bool tile_coords(int t, int nN, int& pm, int& pn) {
  const int per = 8 * nN; const int grp = t / per, within = t - grp * per;
  pm = grp * 8 + (within & 7); pn = within >> 3; return true;
}
__device__ __forceinline__ int virt_block() {
  const int G = gridDim.x; if (G & 7) return blockIdx.x; return (blockIdx.x & 7) * (G >> 3) + (blockIdx.x >> 3);
}
__device__ __forceinline__ void zero_acc(f32x16 (&acc)[2][2]) {
#pragma unroll
  for (int a = 0; a < 2; ++a)
#pragma unroll
    for (int b = 0; b < 2; ++b)
#pragma unroll
      for (int i = 0; i < 16; ++i) acc[a][b][i] = 0.f;
}

__device__ __forceinline__ void phase_gemm_gu(const Params& p, int l, int s, char* smem) {
  const bf16_t* Bt = p.WGU() + (size_t)(l * 2 + s) * 5632 * 1024;
  const int nN = 44, ntiles = 48 * 44, G = gridDim.x;
  const int lane = opaque_tid() & 63, w = opaque_tid() >> 6, wm = w >> 1, wn = w & 1, l31 = lane & 31, hf = lane >> 5;
  for (int t = virt_block(); t < ntiles; t += G) {
    int pm, pn; tile_coords(t, nN, pm, pn);
    f32x16 acc[2][2]; zero_acc(acc);
    gemm_kloop(p.H() + (size_t)pm * 256 * 1024, 1024, Bt + (size_t)pn * 128 * 1024, 1024, 1024, acc, smem);
    const int rowbase = pm * 256 + wm * 64, colbase = pn * 128 + wn * 64;
#pragma unroll
    for (int mi = 0; mi < 2; ++mi) {
      const int token = rowbase + 32 * mi + l31;
#pragma unroll
      for (int g = 0; g < 4; ++g) {
        float o[4];
#pragma unroll
        for (int e = 0; e < 4; ++e) { float gt = acc[mi][0][4 * g + e], up = acc[mi][1][4 * g + e]; o[e] = siluf_(gt) * up; }
        store_bf4(p.ACT() + (size_t)token * DFF + (colbase >> 1) + 8 * g + 4 * hf, o[0], o[1], o[2], o[3]);
      }
    }
  }
}

__device__ __forceinline__ void phase_gemm_y(const Params& p, const bf16_t* A, int K, const bf16_t* Bt, char* smem) {
  const int nN = 8, ntiles = 48 * 8, G = gridDim.x;
  const int lane = opaque_tid() & 63, w = opaque_tid() >> 6, wm = w >> 1, wn = w & 1, l31 = lane & 31, hf = lane >> 5;
  for (int t = virt_block(); t < ntiles; t += G) {
    int pm, pn; tile_coords(t, nN, pm, pn);
    f32x16 acc[2][2]; zero_acc(acc);
    gemm_kloop(A + (size_t)pm * 256 * K, K, Bt + (size_t)pn * 128 * K, K, K, acc, smem);
    const int rowbase = pm * 256 + wm * 64, colbase = pn * 128 + wn * 64;
#pragma unroll
    for (int mi = 0; mi < 2; ++mi) {
      const int token = rowbase + 32 * mi + l31;
#pragma unroll
      for (int ni = 0; ni < 2; ++ni)
#pragma unroll
        for (int g = 0; g < 4; ++g) {
          f32x4 v = {acc[mi][ni][4 * g], acc[mi][ni][4 * g + 1], acc[mi][ni][4 * g + 2], acc[mi][ni][4 * g + 3]};
          *(f32x4*)(p.Y() + (size_t)token * DM + colbase + 32 * ni + 8 * g + 4 * hf) = v;
        }
    }
  }
}

__device__ __forceinline__ void phase_gemm_br(const Params& p, int l, char* smem) {
  const int nN = 8, ntiles = 48 * 8, G = gridDim.x;
  const int lane = opaque_tid() & 63, w = opaque_tid() >> 6, wm = w >> 1, wn = w & 1, l31 = lane & 31, hf = lane >> 5;
  for (int t = virt_block(); t < ntiles; t += G) {
    int pm, pn; tile_coords(t, nN, pm, pn);
    f32x16 tot[2][2]; zero_acc(tot);
    const int rowbase = pm * 256 + wm * 64, colbase = pn * 128 + wn * 64;
#pragma unroll 1
    for (int br = 0; br < 3; ++br) {
      const bf16_t* A = br == 0 ? p.OA() : (br == 1 ? p.OBR() : p.OC());
      const bf16_t* Bt = p.WBR() + (size_t)(l * 3 + br) * 1024 * 512;
      f32x16 acc[2][2]; zero_acc(acc);
      gemm_kloop(A + (size_t)pm * 256 * 512, 512, Bt + (size_t)pn * 128 * 512, 512, 512, acc, smem);
#pragma unroll
      for (int mi = 0; mi < 2; ++mi) {
        const int token = rowbase + 32 * mi + l31;
#pragma unroll
        for (int ni = 0; ni < 2; ++ni)
#pragma unroll
          for (int g = 0; g < 4; ++g) {
            uint2 gv = *(const uint2*)(p.GATE() + (size_t)token * 3072 + br * 1024 + colbase + 32 * ni + 8 * g + 4 * hf);
            tot[mi][ni][4 * g + 0] += __uint_as_float(gv.x << 16) * acc[mi][ni][4 * g + 0];
            tot[mi][ni][4 * g + 1] += __uint_as_float(gv.x & 0xffff0000u) * acc[mi][ni][4 * g + 1];
            tot[mi][ni][4 * g + 2] += __uint_as_float(gv.y << 16) * acc[mi][ni][4 * g + 2];
            tot[mi][ni][4 * g + 3] += __uint_as_float(gv.y & 0xffff0000u) * acc[mi][ni][4 * g + 3];
          }
      }
    }
#pragma unroll
    for (int mi = 0; mi < 2; ++mi) {
      const int token = rowbase + 32 * mi + l31;
#pragma unroll
      for (int ni = 0; ni < 2; ++ni)
#pragma unroll
        for (int g = 0; g < 4; ++g)
          store_bf4(p.MERGED() + (size_t)token * DM + colbase + 32 * ni + 8 * g + 4 * hf, tot[mi][ni][4 * g], tot[mi][ni][4 * g + 1], tot[mi][ni][4 * g + 2], tot[mi][ni][4 * g + 3]);
    }
  }
}

__device__ __forceinline__ void rope_apply(f32x16& a, const float* cs, const float* sn, int pos, int hf) {
#pragma unroll
  for (int gg = 0; gg < 2; ++gg) {
    f32x4 c4 = *(const f32x4*)(cs + pos * 16 + 8 * gg + 4 * hf);
    f32x4 s4 = *(const f32x4*)(sn + pos * 16 + 8 * gg + 4 * hf);
#pragma unroll
    for (int e = 0; e < 4; ++e) {
      const int i = 4 * gg + e; float x1 = a[i], x2 = a[i + 8];
      a[i] = x1 * c4[e] - x2 * s4[e]; a[i + 8] = x2 * c4[e] + x1 * s4[e];
    }
  }
}

namespace pg8 {
#define PG8_LAS __attribute__((address_space(3)))
constexpr int BM = 256, BK = 64, HALF = 128, HTB = HALF * BK * 2, STAGE_BYTES = 8 * HTB, NXCD = 8, WGM = 8;
__device__ __forceinline__ int lds_byte(int r, int c) { const int st = (r >> 4) * 2 + (c >> 5), rr = r & 15, cc = c & 31, ob = rr * 64 + cc * 2; return st * 1024 + (ob ^ (((ob >> 9) & 1) << 5)); }
__device__ __forceinline__ void stage_rc(int b, int& R, int& C) { const int st = b / 1024, sb = b % 1024, swz = sb ^ (((sb >> 9) & 1) << 5); R = (st >> 1) * 16 + swz / 64; C = (st & 1) * 32 + (swz % 64) / 2; }
__device__ __forceinline__ int perm32(int rho) { const int n = rho >> 4, i = rho & 15; return 8 * (i >> 2) + 4 * n + (i & 3); }
struct Unit { int pm, pn, br; };
struct Gemm { const bf16_t* A; const bf16_t* Bt; int M, N, K; };
struct StaticOrder {
    int nM, nN, nwg, G, c;
    __device__ __forceinline__ void init(int M, int N, int G_, int c_) { nM = M / BM; nN = N / BM; nwg = nM * nN; G = G_; c = c_; }
    __device__ __forceinline__ bool next(int i, Unit& u) const {
        const long L = (long)i * G + c; if (L >= nwg) return false;
        int wgid = (int)L; { const int q = nwg / NXCD, r = nwg % NXCD, xcd = wgid % NXCD, off = wgid / NXCD; wgid = (xcd < r ? xcd * (q + 1) : r * (q + 1) + (xcd - r) * q) + off; }
        const int nig = WGM * nN, gid = wgid / nig, fm = gid * WGM, gsz = (nM - fm) < WGM ? (nM - fm) : WGM;
        u.pm = fm + ((wgid % nig) % gsz); u.pn = (wgid % nig) / gsz; u.br = 0; return true;
    }
    __device__ __forceinline__ const char* Aof(const Gemm& g, const Unit& u, size_t tstep) const { return (const char*)g.A + (size_t)u.pm * tstep; }
    __device__ __forceinline__ const char* Bof(const Gemm& g, const Unit& u, size_t tstep) const { return (const char*)g.Bt + (size_t)u.pn * tstep; }
};
struct BranchOrder : StaticOrder {
    size_t strideA, strideB;
    __device__ __forceinline__ bool next(int j, Unit& u) const { const int i = j / 3; if (!StaticOrder::next(i, u)) return false; u.br = j - 3 * i; return true; }
    __device__ __forceinline__ const char* Aof(const Gemm& g, const Unit& u, size_t tstep) const { return (const char*)g.A + (size_t)u.br * strideA + (size_t)u.pm * tstep; }
    __device__ __forceinline__ const char* Bof(const Gemm& g, const Unit& u, size_t tstep) const { return (const char*)g.Bt + (size_t)u.br * strideB + (size_t)u.pn * tstep; }
};
template <class Epi, class Sched>
__device__ __forceinline__ void gemm_phase(PG8_LAS unsigned char* lds, const Gemm g, const Sched& S, const Epi& E) {
    const int tid = opaque_tid(), wid = __builtin_amdgcn_readfirstlane(tid >> 6), lane = tid & 63, wr = wid >> 2, wc = wid & 3, fr = lane & 15, fq = lane >> 4;
    const int K = g.K, nt = K / BK;
    unsigned voffA[2], voffB[2];
#pragma unroll
    for (int i = 0; i < 2; ++i) { int R, C; stage_rc(tid * 16 + i * 8192, R, C); const int Rb = Epi::PERM ? ((R & ~31) + perm32(R & 31)) : R;
        voffA[i] = (unsigned)(R * K + C) * 2u; voffB[i] = (unsigned)(Rb * K + C) * 2u; }
    const size_t kstep = (size_t)(BK * 2);
    const size_t hstep = (size_t)HALF * K * 2;
    const size_t tstep = 2 * hstep;
    const unsigned ldsw = (unsigned)wid * 1024u;
    const int aoff = lds_byte(wr * 64 + fr, fq * 8), boff = lds_byte(wc * 32 + fr, fq * 8);
#define PG8_SA(b, h) (((b) * 2 + (h)) * HTB)
#define PG8_SB(b, h) ((4 + (b) * 2 + (h)) * HTB)
#define PG8_STAGE(bufoff, gbase, voff) do { _Pragma("unroll") for (int _i = 0; _i < 2; ++_i) \
        __builtin_amdgcn_global_load_lds((const unsigned*)((const char*)(gbase) + (voff)[_i]), (PG8_LAS unsigned*)(lds + (bufoff) + ldsw + _i * 8192), 16, 0, 0); } while (0)
#define PG8_LDA(dst, b, h) do { _Pragma("unroll") for (int m = 0; m < 4; ++m) _Pragma("unroll") for (int k = 0; k < 2; ++k) dst[m][k] = *(const PG8_LAS bf16x8*)(lds + PG8_SA(b, h) + aoff + m * 2048 + k * 1024); } while (0)
#define PG8_LDB(dst, b, h) do { _Pragma("unroll") for (int n = 0; n < 2; ++n) _Pragma("unroll") for (int k = 0; k < 2; ++k) dst[n][k] = *(const PG8_LAS bf16x8*)(lds + PG8_SB(b, h) + boff + n * 2048 + k * 1024); } while (0)
#define PG8_MMA(ai, bj, At, Bt) do { __builtin_amdgcn_s_setprio(1); _Pragma("unroll") for (int m = 0; m < 4; ++m) _Pragma("unroll") for (int n = 0; n < 2; ++n) _Pragma("unroll") for (int k = 0; k < 2; ++k) \
        acc[ai][bj][m][n] = __builtin_amdgcn_mfma_f32_16x16x32_bf16(Bt[n][k], At[m][k], acc[ai][bj][m][n], 0, 0, 0); __builtin_amdgcn_s_setprio(0); } while (0)
#define PG8_WAIT_V(n) asm volatile("s_waitcnt vmcnt(" #n ")" ::: "memory")
#define PG8_WAIT_L(n) asm volatile("s_waitcnt lgkmcnt(" #n ")" ::: "memory")
#define PG8_BAR __builtin_amdgcn_s_barrier()
#define PG8_SCHED __builtin_amdgcn_sched_barrier(0)
    Unit cur, nxt; int ui = 0;
    if (!S.next(0, cur)) return;
    f32x4 acc[2][2][4][2];
#pragma unroll
    for (int a = 0; a < 2; ++a)
#pragma unroll
        for (int b = 0; b < 2; ++b)
#pragma unroll
            for (int m = 0; m < 4; ++m)
#pragma unroll
                for (int n = 0; n < 2; ++n) acc[a][b][m][n] = (f32x4){0.f, 0.f, 0.f, 0.f};
    bf16x8 At[4][2], B0[2][2], B1[2][2];
    const char* cA = S.Aof(g, cur, tstep); const char* cB = S.Bof(g, cur, tstep);
    PG8_STAGE(PG8_SB(0, 0), cB, voffB); PG8_STAGE(PG8_SA(0, 0), cA, voffA); PG8_STAGE(PG8_SB(0, 1), cB + hstep, voffB); PG8_STAGE(PG8_SA(0, 1), cA + hstep, voffA);
    if (wr == 1) PG8_BAR;
    PG8_WAIT_V(4); PG8_BAR;
    PG8_STAGE(PG8_SB(1, 0), cB + kstep, voffB); PG8_STAGE(PG8_SA(1, 0), cA + kstep, voffA); PG8_STAGE(PG8_SB(1, 1), cB + hstep + kstep, voffB);
    PG8_WAIT_V(6); PG8_BAR;
    for (;;) {
        const bool has_next = S.next(ui + 1, nxt);
        const char* nA = has_next ? S.Aof(g, nxt, tstep) : cA; const char* nB = has_next ? S.Bof(g, nxt, tstep) : cB;
        for (int t = 0; t < nt; t += 2) {
            const bool last = (t == nt - 2);
            const char* a1 = cA + (size_t)(t + 1) * kstep;
            const char* a2 = last ? nA : cA + (size_t)(t + 2) * kstep; const char* b2 = last ? nB : cB + (size_t)(t + 2) * kstep;
            const char* a3 = a2 + kstep; const char* b3 = b2 + kstep;
            PG8_LDB(B0, 0, 0); PG8_SCHED; PG8_LDA(At, 0, 0); PG8_STAGE(PG8_SA(1, 1), a1 + hstep, voffA);
            PG8_WAIT_L(8); PG8_BAR; PG8_WAIT_L(0); PG8_MMA(0, 0, At, B0); PG8_BAR; PG8_SCHED;
            PG8_LDB(B1, 0, 1); PG8_STAGE(PG8_SB(0, 0), b2, voffB);
            PG8_BAR; PG8_WAIT_L(0); PG8_MMA(0, 1, At, B1); PG8_BAR;
            PG8_LDA(At, 0, 1); PG8_STAGE(PG8_SA(0, 0), a2, voffA);
            PG8_BAR; PG8_WAIT_L(0); PG8_MMA(1, 0, At, B0); PG8_BAR; PG8_SCHED;
            PG8_STAGE(PG8_SB(0, 1), b2 + hstep, voffB);
            PG8_WAIT_V(6); PG8_BAR; PG8_MMA(1, 1, At, B1); PG8_BAR;
            PG8_LDB(B0, 1, 0); PG8_SCHED; PG8_LDA(At, 1, 0); PG8_STAGE(PG8_SA(0, 1), a2 + hstep, voffA);
            PG8_WAIT_L(8); PG8_BAR; PG8_WAIT_L(0); PG8_MMA(0, 0, At, B0); PG8_BAR; PG8_SCHED;
            PG8_LDB(B1, 1, 1); PG8_STAGE(PG8_SB(1, 0), b3, voffB);
            PG8_BAR; PG8_WAIT_L(0); PG8_MMA(0, 1, At, B1); PG8_BAR;
            PG8_LDA(At, 1, 1); PG8_STAGE(PG8_SA(1, 0), a3, voffA);
            PG8_BAR; PG8_WAIT_L(0); PG8_MMA(1, 0, At, B0); PG8_BAR; PG8_SCHED;
            PG8_STAGE(PG8_SB(1, 1), b3 + hstep, voffB);
            PG8_WAIT_V(6); PG8_BAR; PG8_MMA(1, 1, At, B1); PG8_BAR;
        }
        if constexpr (Epi::CHAIN) E.chain(acc, cur, wr, wc, fr, fq); else E(acc, cur, wr, wc, fr, fq);
        if (!has_next) break;
        if (!(Epi::CHAIN && cur.br < 2)) {
#pragma unroll
        for (int a = 0; a < 2; ++a)
#pragma unroll
            for (int b = 0; b < 2; ++b)
#pragma unroll
                for (int m = 0; m < 4; ++m)
#pragma unroll
                    for (int n = 0; n < 2; ++n) acc[a][b][m][n] = (f32x4){0.f, 0.f, 0.f, 0.f};
        }
        cur = nxt; cA = nA; cB = nB; ++ui;
    }
    PG8_WAIT_V(0);
    if (wr == 0) PG8_BAR;
    PG8_BAR;
#undef PG8_SA
#undef PG8_SB
#undef PG8_STAGE
#undef PG8_LDA
#undef PG8_LDB
#undef PG8_MMA
#undef PG8_WAIT_V
#undef PG8_WAIT_L
#undef PG8_BAR
#undef PG8_SCHED
}
}

struct EpiGU {
  static constexpr bool PERM = true, CHAIN = false;
  bf16_t* ACT;
  __device__ __forceinline__ void operator()(const f32x4 (&acc)[2][2][4][2], const pg8::Unit& u, int wr, int wc, int fr, int fq) const {
#pragma unroll
    for (int ai = 0; ai < 2; ++ai)
#pragma unroll
      for (int m = 0; m < 4; ++m) {
        const int row = u.pm * 256 + ai * 128 + wr * 64 + m * 16 + fr;
        const int f = 128 * u.pn + 32 * wc + 8 * fq;
        const f32x4 g0 = acc[ai][0][m][0], g1 = acc[ai][0][m][1], u0 = acc[ai][1][m][0], u1 = acc[ai][1][m][1];
        u32x4 o;
        o.x = pk2(siluf_(g0[0]) * u0[0], siluf_(g0[1]) * u0[1]); o.y = pk2(siluf_(g0[2]) * u0[2], siluf_(g0[3]) * u0[3]);
        o.z = pk2(siluf_(g1[0]) * u1[0], siluf_(g1[1]) * u1[1]); o.w = pk2(siluf_(g1[2]) * u1[2], siluf_(g1[3]) * u1[3]);
        *(u32x4*)(ACT + (size_t)row * DFF + f) = o;
      }
  }
};
struct EpiY {
  static constexpr bool PERM = true, CHAIN = false;
  bf16_t* Y;
  __device__ __forceinline__ void operator()(const f32x4 (&acc)[2][2][4][2], const pg8::Unit& u, int wr, int wc, int fr, int fq) const {
#pragma unroll
    for (int ai = 0; ai < 2; ++ai)
#pragma unroll
      for (int m = 0; m < 4; ++m) {
        bf16_t* rp = Y + (size_t)(u.pm * 256 + ai * 128 + wr * 64 + m * 16 + fr) * DM + u.pn * 256 + wc * 32 + 8 * fq;
#pragma unroll
        for (int bj = 0; bj < 2; ++bj) {
          const f32x4 t0 = acc[ai][bj][m][0], t1 = acc[ai][bj][m][1];
          u32x4 o; o.x = pk2(t0[0], t0[1]); o.y = pk2(t0[2], t0[3]); o.z = pk2(t1[0], t1[1]); o.w = pk2(t1[2], t1[3]);
          *(u32x4*)(rp + bj * 128) = o;
        }
      }
  }
};
struct EpiBR {
  static constexpr bool PERM = true, CHAIN = true;
  const bf16_t* GATE; bf16_t* MERGED;
  __device__ __forceinline__ void chain(f32x4 (&acc)[2][2][4][2], const pg8::Unit& u, int wr, int wc, int fr, int fq) const {
#pragma unroll
    for (int ai = 0; ai < 2; ++ai)
#pragma unroll
      for (int m = 0; m < 4; ++m) {
        const size_t row = (size_t)(u.pm * 256 + ai * 128 + wr * 64 + m * 16 + fr);
#pragma unroll
        for (int bj = 0; bj < 2; ++bj) {
          const int col = u.pn * 256 + bj * 128 + wc * 32 + 8 * fq;
          const bf16_t* gp = GATE + row * 3072 + u.br * 1024 + col;
          const u32x4 gv = *(const u32x4*)gp;
          float g[8] = {__uint_as_float(gv.x << 16), __uint_as_float(gv.x & 0xffff0000u), __uint_as_float(gv.y << 16), __uint_as_float(gv.y & 0xffff0000u),
                        __uint_as_float(gv.z << 16), __uint_as_float(gv.z & 0xffff0000u), __uint_as_float(gv.w << 16), __uint_as_float(gv.w & 0xffff0000u)};
          if (u.br < 2) {
            const u32x4 hv = *(const u32x4*)(gp + 1024);
            const float h[8] = {__uint_as_float(hv.x << 16), __uint_as_float(hv.x & 0xffff0000u), __uint_as_float(hv.y << 16), __uint_as_float(hv.y & 0xffff0000u),
                                __uint_as_float(hv.z << 16), __uint_as_float(hv.z & 0xffff0000u), __uint_as_float(hv.w << 16), __uint_as_float(hv.w & 0xffff0000u)};
#pragma unroll
            for (int e = 0; e < 8; ++e) g[e] = fmaxf(g[e], 1e-30f) * __builtin_amdgcn_rcpf(fmaxf(h[e], 1e-30f));
          } else {
#pragma unroll
            for (int e = 0; e < 8; ++e) g[e] = fmaxf(g[e], 1e-30f);
          }
          f32x4 t0 = acc[ai][bj][m][0], t1 = acc[ai][bj][m][1];
          t0[0] *= g[0]; t0[1] *= g[1]; t0[2] *= g[2]; t0[3] *= g[3]; t1[0] *= g[4]; t1[1] *= g[5]; t1[2] *= g[6]; t1[3] *= g[7];
          if (u.br < 2) { acc[ai][bj][m][0] = t0; acc[ai][bj][m][1] = t1; }
          else { u32x4 o; o.x = pk2(t0[0], t0[1]); o.y = pk2(t0[2], t0[3]); o.z = pk2(t1[0], t1[1]); o.w = pk2(t1[2], t1[3]); *(u32x4*)(MERGED + row * DM + col) = o; }
        }
      }
  }
};
template <int TY> __device__ __forceinline__ void win_epi_row(const Params& p, int l, bool lat, int token, int G0, int fq, f32x4 v0, f32x4 v1, f32x4 v2, f32x4 v3) {
  if (TY == 0) __builtin_assume(G0 < 1024);
  if (TY == 1) __builtin_assume(G0 >= 1024 && G0 < 1536);
  if (TY == 2) __builtin_assume(G0 >= 1536 && G0 < 4096);
  if (TY == 3) __builtin_assume(G0 >= 4096 && G0 < 4736);
  if (TY == 4) __builtin_assume(G0 >= 4736 && G0 < 4864);
  if (TY == 5) __builtin_assume(G0 >= 4864);
  f32x4 v[4] = {v0, v1, v2, v3};
  int b, tt;
  if (lat) { b = (token - NPR) >> 11; tt = (token - NPR) & 2047; } else { b = token >> 8; tt = token & 255; }
  const bool isn = (G0 >= 4096 && G0 < 4736);
  if (isn) {
    float ss = 0.f;
#pragma unroll
    for (int j = 0; j < 4; ++j) ss += v[j][0] * v[j][0] + v[j][1] * v[j][1] + v[j][2] * v[j][2] + v[j][3] * v[j][3];
    ss += __shfl_xor(ss, 16); ss += __shfl_xor(ss, 32);
    const float r = rsqrtf(ss * (1.f / 64.f) + EPSV);
    const float* nw = p.in[G0 < 4608 ? I_QNORM : I_KNORM] + l * 64;
#pragma unroll
    for (int j = 0; j < 4; ++j) {
      const f32x4 w4 = *(const f32x4*)(nw + 16 * j + 4 * fq);
      v[j][0] *= r * w4[0]; v[j][1] *= r * w4[1]; v[j][2] *= r * w4[2]; v[j][3] *= r * w4[3];
    }
  }
  if (lat && (G0 < 1024 || isn)) {
#pragma unroll
    for (int bj = 0; bj < 2; ++bj) {
      const int pos = bj ? (tt & 63) : (tt >> 6);
      const f32x4 c4 = *(const f32x4*)(p.ROPE_COS() + pos * 16 + 4 * fq), s4 = *(const f32x4*)(p.ROPE_SIN() + pos * 16 + 4 * fq);
#pragma unroll
      for (int e = 0; e < 4; ++e) {
        const float x1 = v[2 * bj][e], x2 = v[2 * bj + 1][e];
        v[2 * bj][e] = x1 * c4[e] - x2 * s4[e]; v[2 * bj + 1][e] = x2 * c4[e] + x1 * s4[e];
      }
    }
  }
#pragma unroll
  for (int j = 0; j < 4; ++j) {
    const int col = G0 + 16 * j + 4 * fq;
    const f32x4 x = v[j];
    if (G0 < 512) {
      store_bf4(p.QA() + (size_t)token * 512 + col, x[0], x[1], x[2], x[3]);
    } else if (G0 < 1024) {
      const int c = col - 512;
      bf16_t* kd = lat ? p.KA_lat() + ((size_t)b * SLAT + 256 + tt) * 512 : p.KA_ctx() + (size_t)token * 512;
      store_bf4(kd + c, x[0], x[1], x[2], x[3]);
      if (!lat) *(f32x4*)(p.out + OUT_AK + ((size_t)(b * 4 + l) * 256 + tt) * 512 + c) = x;
    } else if (G0 < 1536) {
      const int c = col - 1024;
      const int S = lat ? SLAT : 256; const int key = lat ? 256 + tt : tt;
      bf16_t* vt = lat ? p.VTA_lat() : p.VTA_ctx();
      const unsigned vo = (unsigned)(b * 512 + c) * (unsigned)S + (unsigned)key;
      if (!lat) *(f32x4*)(p.out + OUT_AV + ((size_t)(b * 4 + l) * 256 + tt) * 512 + c) = x;
#pragma unroll
      for (int e = 0; e < 4; ++e) vt[vo + (unsigned)(e * S)] = f2bf(x[e]);
    } else if (G0 < 4096) {
      const int kind = (G0 - 1536) >> 9;
      const int c = (col - 1536) & 511;
      const size_t off = (size_t)token * 512 + c;
      if (kind == 0) {
        store_bf4(p.BQ() + off, siluf_(x[0]) * 0.08838834764831845f, siluf_(x[1]) * 0.08838834764831845f, siluf_(x[2]) * 0.08838834764831845f, siluf_(x[3]) * 0.08838834764831845f);
      } else if (kind == 1) {
        store_bf4(p.BI() + off, x[0], x[1], x[2], x[3]);
      } else if (kind == 4) {
        store_bf4(p.BG() + off, siluf_(x[0]), siluf_(x[1]), siluf_(x[2]), siluf_(x[3]));
      } else {
        const int d = kind - 2;
        const f32x4 lb4 = *(const f32x4*)(p.LB() + (d * 4 + l) * 512 + c);
        float kk[4], lf[4];
#pragma unroll
        for (int e = 0; e < 4; ++e) {
          const float z = x[e], lb = lb4[e];
          kk[e] = (1.f - lb) * __builtin_amdgcn_rcpf(1.f + __expf(z));
          const float ls = -(fmaxf(-z, 0.f) + __logf(1.f + __expf(-fabsf(z))));
          lf[e] = (lb <= 0.f) ? ls : __logf(lb + (1.f - lb) * __builtin_amdgcn_rcpf(1.f + __expf(-z)));
        }
        store_bf4((d ? p.KKB() : p.KKF()) + off, kk[0], kk[1], kk[2], kk[3]);
        *(f32x4*)((d ? p.LOGFB() : p.LOGFF()) + off) = (f32x4){lf[0], lf[1], lf[2], lf[3]};
      }
    } else if (G0 < 4608) {
      store_bf4(p.QC() + (size_t)token * 512 + col - 4096, x[0], x[1], x[2], x[3]);
    } else if (G0 < 4736) {
      const int c = col - 4608;
      bf16_t* kd = lat ? p.KC_lat() + ((size_t)b * SLAT + 256 + tt) * 128 : p.KC_ctx() + (size_t)token * 128;
      store_bf4(kd + c, x[0], x[1], x[2], x[3]);
      if (!lat) *(f32x4*)(p.out + OUT_CK + ((size_t)(b * 4 + l) * 256 + tt) * 128 + c) = x;
    } else if (G0 < 4864) {
      const int c = col - 4736;
      const int S = lat ? SLAT : 256; const int key = lat ? 256 + tt : tt;
      bf16_t* vt = lat ? p.VTC_lat() : p.VTC_ctx();
      const unsigned vo = (unsigned)(b * 128 + c) * (unsigned)S + (unsigned)key;
      if (!lat) *(f32x4*)(p.out + OUT_CV + ((size_t)(b * 4 + l) * 256 + tt) * 128 + c) = x;
#pragma unroll
      for (int e = 0; e < 4; ++e) vt[vo + (unsigned)(e * S)] = f2bf(x[e]);
    } else {
      store_bf4(p.GATE() + (size_t)token * 3072 + col - 4864, sigmoidf_(x[0]), sigmoidf_(x[1]), sigmoidf_(x[2]), sigmoidf_(x[3]));
    }
  }
}
struct EpiWIN {
  static constexpr bool PERM = false, CHAIN = false;
  const Params& p; int l;
  __device__ __forceinline__ void operator()(const f32x4 (&acc)[2][2][4][2], const pg8::Unit& u, int wr, int wc, int fr, int fq) const {
    const int G0 = u.pn * 256 + wc * 64;
    const int row0 = u.pm * 256 + wr * 64 + fr;
    const bool lat = u.pm >= 16;
#define WIN_ROW(TY, ai, m) win_epi_row<TY>(p, l, lat, row0 + (ai) * 128 + (m) * 16, G0, fq, acc[ai][0][m][0], acc[ai][0][m][1], acc[ai][1][m][0], acc[ai][1][m][1]);
#define WIN_ROWS(TY) { WIN_ROW(TY, 0, 0) WIN_ROW(TY, 0, 1) WIN_ROW(TY, 0, 2) WIN_ROW(TY, 0, 3) WIN_ROW(TY, 1, 0) WIN_ROW(TY, 1, 1) WIN_ROW(TY, 1, 2) WIN_ROW(TY, 1, 3) }
    if (G0 < 1024) WIN_ROWS(0)
    else if (G0 < 1536) WIN_ROWS(1)
    else if (G0 < 4096) WIN_ROWS(2)
    else if (G0 < 4736) WIN_ROWS(3)
    else if (G0 < 4864) WIN_ROWS(4)
    else WIN_ROWS(5)
#undef WIN_ROWS
#undef WIN_ROW
  }
};

__device__ __forceinline__ void phase_gemm_gu2(const Params& p, int l, int s, PG8_LAS unsigned char* lds) {
  pg8::Gemm g{p.H(), p.WGU() + (size_t)(l * 2 + s) * 5632 * 1024, NT, 5632, 1024};
  pg8::StaticOrder S; S.init(NT, 5632, (int)gridDim.x, (int)blockIdx.x);
  EpiGU E{p.ACT()};
  pg8::gemm_phase<EpiGU, pg8::StaticOrder>(lds, g, S, E);
}
__device__ __forceinline__ void phase_gemm_y2(const Params& p, const bf16_t* A, int K, const bf16_t* Bt, PG8_LAS unsigned char* lds) {
  pg8::Gemm g{A, Bt, NT, 1024, K};
  pg8::StaticOrder S; S.init(NT, 1024, (int)gridDim.x, (int)blockIdx.x);
  EpiY E{(bf16_t*)p.Y()};
  pg8::gemm_phase<EpiY, pg8::StaticOrder>(lds, g, S, E);
}
__device__ __forceinline__ void phase_gemm_win2(const Params& p, int l, PG8_LAS unsigned char* lds) {
  pg8::Gemm g{p.H(), p.WIN() + (size_t)l * DIN * 1024, NT, DIN, 1024};
  pg8::StaticOrder S; S.init(NT, DIN, (int)gridDim.x, (int)blockIdx.x);
  EpiWIN E{p, l};
  pg8::gemm_phase<EpiWIN, pg8::StaticOrder>(lds, g, S, E);
}

__device__ __forceinline__ void phase_gemm_br2(const Params& p, int l, PG8_LAS unsigned char* lds) {
  pg8::Gemm g{p.OA(), p.WBR() + (size_t)l * 3 * 1024 * 512, NT, 1024, 512};
  pg8::BranchOrder S; S.init(NT, 1024, (int)gridDim.x, (int)blockIdx.x);
  S.strideA = O_OBR - O_OA; S.strideB = (size_t)1024 * 512 * 2;
  EpiBR E{p.GATE(), p.MERGED()};
  pg8::gemm_phase<EpiBR, pg8::BranchOrder>(lds, g, S, E);
}

__device__ __forceinline__ void phase_rowwise(const Params& p, bool first, int lpost, int spost, float coef, int cgate, int lpre, int spre, int cshift, int cscale) {
  const int lane = opaque_tid() & 63, w = opaque_tid() >> 6;
  for (int grp = blockIdx.x; grp < NT / 8; grp += gridDim.x) {
    const int row = grp * 8 + w;
    const int ci = row < NPR ? 0 : 1 + ((row - NPR) >> 11);
    f32x4 x[4];
    float* X = p.out + (size_t)row * DM;
    if (first) {
      const float* src = row < NPR ? p.in[I_XP] + (size_t)row * DM : p.in[I_XS] + (size_t)(row - NPR) * DM;
#pragma unroll
      for (int j = 0; j < 4; ++j) x[j] = *(const f32x4*)(src + lane * 4 + 256 * j);
    } else {
#pragma unroll
      for (int j = 0; j < 4; ++j) x[j] = *(const f32x4*)(X + lane * 4 + 256 * j);
    }
    if (lpost >= 0) {
      f32x4 y[4]; float ss = 0.f;
#pragma unroll
      for (int j = 0; j < 4; ++j) { const u32x2 yr = *(const u32x2*)((const bf16_t*)p.Y() + (size_t)row * DM + lane * 4 + 256 * j); y[j][0] = __uint_as_float(yr.x << 16); y[j][1] = __uint_as_float(yr.x & 0xffff0000u); y[j][2] = __uint_as_float(yr.y << 16); y[j][3] = __uint_as_float(yr.y & 0xffff0000u); ss += y[j][0] * y[j][0] + y[j][1] * y[j][1] + y[j][2] * y[j][2] + y[j][3] * y[j][3]; }
      ss = wave_sum(ss);
      const float r = rsqrtf(ss * (1.f / 1024.f) + EPSV) * coef;
      const float* md = p.MOD() + (size_t)(lpost * 5 + ci) * 9216 + cgate * 1024;
      const float* gp = p.in[I_NPOST] + (lpost * 3 + spost) * 1024;
#pragma unroll
      for (int j = 0; j < 4; ++j) {
        f32x4 m4 = *(const f32x4*)(md + lane * 4 + 256 * j), g4 = *(const f32x4*)(gp + lane * 4 + 256 * j);
#pragma unroll
        for (int e = 0; e < 4; ++e) x[j][e] += m4[e] * (y[j][e] * r * g4[e]);
      }
    }
    if (first || lpost >= 0) {
#pragma unroll
      for (int j = 0; j < 4; ++j) *(f32x4*)(X + lane * 4 + 256 * j) = x[j];
    }
    if (lpre >= 0) {
      float ss = 0.f;
#pragma unroll
      for (int j = 0; j < 4; ++j) ss += x[j][0] * x[j][0] + x[j][1] * x[j][1] + x[j][2] * x[j][2] + x[j][3] * x[j][3];
      ss = wave_sum(ss);
      const float r = rsqrtf(ss * (1.f / 1024.f) + EPSV);
      const float* msh = p.MOD() + (size_t)(lpre * 5 + ci) * 9216 + cshift * 1024;
      const float* msc = p.MOD() + (size_t)(lpre * 5 + ci) * 9216 + cscale * 1024;
      const float* gp = p.in[I_NPRE] + (lpre * 3 + spre) * 1024;
#pragma unroll
      for (int j = 0; j < 4; ++j) {
        f32x4 sh = *(const f32x4*)(msh + lane * 4 + 256 * j), sc = *(const f32x4*)(msc + lane * 4 + 256 * j), g4 = *(const f32x4*)(gp + lane * 4 + 256 * j);
        float h[4];
#pragma unroll
        for (int e = 0; e < 4; ++e) h[e] = x[j][e] * r * g4[e] * (1.f + sc[e]) + sh[e];
        store_bf4(p.H() + (size_t)row * DM + lane * 4 + 256 * j, h[0], h[1], h[2], h[3]);
      }
    }
  }
}

__device__ __forceinline__ void cache_convert(const Params& p, int l) {
  const int gtid = blockIdx.x * NTHR + opaque_tid(), gsz = gridDim.x * NTHR;
  for (int i = gtid; i < 4 * 256 * 512; i += gsz) {
    const int c = i & 511, s = (i >> 9) & 255, b = i >> 17;
    const size_t src = ((size_t)(b * 4 + l) * 256 + s) * 512 + c;
    p.KA_lat()[((size_t)b * SLAT + s) * 512 + c] = f2bf(p.in[I_CAK][src]);
    p.VTA_lat()[((size_t)b * 512 + c) * SLAT + s] = f2bf(p.in[I_CAV][src]);
  }
  for (int i = gtid; i < 4 * 256 * 128; i += gsz) {
    const int c = i & 127, s = (i >> 7) & 255, b = i >> 15;
    const size_t src = ((size_t)(b * 4 + l) * 256 + s) * 128 + c;
    p.KC_lat()[((size_t)b * SLAT + s) * 128 + c] = f2bf(p.in[I_CCK][src]);
    p.VTC_lat()[((size_t)b * 128 + c) * SLAT + s] = f2bf(p.in[I_CCV][src]);
  }
}

__device__ __forceinline__ void conv_tile(const float* __restrict__ src, int N, bf16_t* __restrict__ dst, int K, int k0, int n0, int mode, float* tile) {
  const int tid = opaque_tid() & 255;
  {
    const int c4 = (tid & 15) * 4, kk = tid >> 4;
    f32x4 v[4];
#pragma unroll
    for (int i = 0; i < 4; ++i) v[i] = *(const f32x4*)(src + (size_t)(k0 + kk + 16 * i) * N + n0 + c4);
#pragma unroll
    for (int i = 0; i < 4; ++i) { float* tp = tile + (kk + 16 * i) * 65 + c4; tp[0] = v[i][0]; tp[1] = v[i][1]; tp[2] = v[i][2]; tp[3] = v[i][3]; }
  }
  __syncthreads();
#pragma unroll
  for (int it = 0; it < 2; ++it) {
    const int nn = (tid >> 3) + 32 * it, kc = tid & 7;
    float v[8];
#pragma unroll
    for (int j = 0; j < 8; ++j) v[j] = tile[(kc * 8 + j) * 65 + nn];
    const int f = n0 + nn;
    int r = f;
    if (mode == 1 || mode == 2) r = (f >> 7) * 256 + (f & 127) + (mode == 2 ? 128 : 0);
    else if (mode == 3) r = (f & ~255) + 128 * ((f >> 5) & 1) + 32 * ((f >> 6) & 3) + (f & 31);
    uint4 u; u.x = pk2(v[0], v[1]); u.y = pk2(v[2], v[3]); u.z = pk2(v[4], v[5]); u.w = pk2(v[6], v[7]);
    *(uint4*)(dst + (size_t)r * K + k0 + kc * 8) = u;
  }
  __syncthreads();
}

__device__ __forceinline__ void phase0(const Params& p, char* smem) {
  const int tid = opaque_tid();
  float* tile = (float*)smem + (tid >> 8) * (64 * 65 + 32);
  const int per_layer = 6848;
  for (int tp = blockIdx.x; tp < 2 * per_layer; tp += gridDim.x) {
    const int t = 2 * tp + (tid >> 8);
    const int l = t / per_layer; int r = t - l * per_layer;
    if (r < 2816) {
      const int j = r / 704, q = r - j * 704, s = j >> 1, isup = j & 1;
      const int kt = q / 44, nt = q - kt * 44;
      const float* src = p.in[isup ? I_FU : I_FG] + (size_t)(l * 2 + s) * 1024 * DFF;
      conv_tile(src, DFF, p.WGU() + (size_t)(l * 2 + s) * 5632 * 1024, 1024, kt * 64, nt * 64, isup ? 2 : 1, tile);
    } else if (r < 4224) {
      r -= 2816; const int s = r / 704, q = r - s * 704; const int kt = q >> 4, nt = q & 15;
      conv_tile(p.in[I_FD] + (size_t)(l * 2 + s) * DFF * 1024, 1024, p.WD() + (size_t)(l * 2 + s) * 1024 * DFF, DFF, kt * 64, nt * 64, 0, tile);
    } else if (r < 6208) {
      r -= 4224; const int kt = r / 124, nt = r - kt * 124;
      conv_tile(p.in[I_WIN] + (size_t)l * 1024 * DIN, DIN, p.WIN() + (size_t)l * DIN * 1024, 1024, kt * 64, nt * 64, 3, tile);
    } else if (r < 6592) {
      r -= 6208; const int br = r >> 7, q = r & 127; const int kt = q >> 4, nt = q & 15;
      const float* src = p.in[I_WBA + br] + (size_t)l * 512 * 1024;
      conv_tile(src, 1024, p.WBR() + (size_t)(l * 3 + br) * 1024 * 512, 512, kt * 64, nt * 64, 0, tile);
    } else {
      r -= 6592; const int kt = r >> 4, nt = r & 15;
      conv_tile(p.in[I_WOUT] + (size_t)l * 1024 * 1024, 1024, p.WOUT() + (size_t)l * 1024 * 1024, 1024, kt * 64, nt * 64, 0, tile);
    }
  }
  {
    float* SC = (float*)smem;
    float* RED = SC + 5 * 1024;
    bool have = false;
    for (int it = blockIdx.x; it < 576; it += gridDim.x) {
      if (!have) {
        __syncthreads();
        for (int i = tid; i < 5 * 1024; i += NTHR) { const float cv = i < 1024 ? p.in[I_CCTX][i] : p.in[I_C][i - 1024]; SC[i] = siluf_(cv); }
        __syncthreads();
        have = true;
      }
      const int l = it / 144, cb = it - l * 144;
      const int lane = tid & 63, w = tid >> 6;
      const int col = cb * 64 + lane;
      const float* wp = p.in[I_ADAW] + ((size_t)l * 1024 + w * 128) * 9216 + col;
      float a0 = 0, a1 = 0, a2 = 0, a3 = 0, a4 = 0;
#pragma unroll 8
      for (int d = 0; d < 128; ++d) {
        const float wv = wp[(size_t)d * 9216]; const int dd = w * 128 + d;
        a0 += SC[dd] * wv; a1 += SC[1024 + dd] * wv; a2 += SC[2048 + dd] * wv; a3 += SC[3072 + dd] * wv; a4 += SC[4096 + dd] * wv;
      }
      RED[(w * 5 + 0) * 64 + lane] = a0; RED[(w * 5 + 1) * 64 + lane] = a1; RED[(w * 5 + 2) * 64 + lane] = a2; RED[(w * 5 + 3) * 64 + lane] = a3; RED[(w * 5 + 4) * 64 + lane] = a4;
      __syncthreads();
      for (int i = tid; i < 320; i += NTHR) {
        const int ci = i >> 6, cl = i & 63;
        float s = 0.f;
#pragma unroll
        for (int ww = 0; ww < 8; ++ww) s += RED[(ww * 5 + ci) * 64 + cl];
        p.MOD()[(size_t)(l * 5 + ci) * 9216 + cb * 64 + cl] = s + p.in[I_ADAB][l * 9216 + cb * 64 + cl];
      }
      __syncthreads();
    }
  }
  const int gtid = blockIdx.x * NTHR + tid, gsz = gridDim.x * NTHR;
  for (int i = gtid; i < 2 * 512; i += gsz) {
    const int d = i >> 9, c = i & 511;
    float r[4], mx = -1e30f;
    for (int j = 0; j < 4; ++j) { r[j] = p.in[I_HLB][(d * 4 + j) * 512 + c]; mx = fmaxf(mx, r[j]); }
    float s = 0; for (int j = 0; j < 4; ++j) { r[j] = expf(r[j] - mx); s += r[j]; }
    float cs = 0;
    for (int j = 0; j < 4; ++j) { if (j > 0) cs += r[j] / s; p.LB()[(d * 4 + j) * 512 + c] = (j == 0) ? 0.f : cs; }
  }
  for (int i = gtid; i < 64 * 16; i += gsz) {
    const int pos = i >> 4, j = i & 15;
    const float fr = powf(10000.f, -(float)j / 16.f);
    const float ang = (float)pos * fr;
    p.ROPE_COS()[i] = cosf(ang); p.ROPE_SIN()[i] = sinf(ang);
  }
  if (gtid < 4) {
    const int l = gtid; const float* lp = p.in[I_DLAM] + l * 256;
    float s1 = 0, s2 = 0;
    for (int j = 0; j < 64; ++j) { s1 += lp[j] * lp[64 + j]; s2 += lp[128 + j] * lp[192 + j]; }
    p.LAM()[l] = expf(s1) - expf(s2) + (0.8f - 0.6f * expf(-0.3f * (float)l));
    p.CTR()[l] = 0u;
  }
}

template <int KW, int DV, bool ISA>
__device__ __forceinline__ void attn_item(const Params& p, int l, const bf16_t* __restrict__ Qw, const bf16_t* __restrict__ Kt, int kpitch, int kwoff,
                          const bf16_t* __restrict__ VT, int S, bf16_t* __restrict__ outp, char* smem) {
  const int tid = opaque_tid(), lane = tid & 63, w = tid >> 6, l31 = lane & 31, hf = lane >> 5;
  constexpr int KP = KW + 8, NV = DV / 32, NKC = KW / 64, NVC = DV / 64;
  bf16_t* Ks = (bf16_t*)smem;
  bf16_t* Vs = Ks + 2 * 64 * KP;
  f32x16 o[NV];
#pragma unroll
  for (int vb = 0; vb < NV; ++vb)
#pragma unroll
    for (int i = 0; i < 16; ++i) o[vb][i] = 0.f;
  float m = -1e30f, lsum = 0.f;
  bf16x8 qf[4];
#pragma unroll
  for (int ks = 0; ks < 4; ++ks) qf[ks] = *(const bf16x8*)(Qw + (size_t)l31 * 512 + ks * 16 + hf * 8);
  const float C = 0.125f * 1.4426950408889634f;
  const int nk = S >> 6;
  u32x4 rk[NKC], rv[NVC];
#define AT_GLOAD(KT_) { \
    _Pragma("unroll") for (int i = 0; i < NKC; ++i) { const int c = tid + NTHR * i; const int key = c / (KW / 8), cc = c % (KW / 8); rk[i] = *(const u32x4*)(Kt + (size_t)((KT_) * 64 + key) * kpitch + cc * 8); } \
    _Pragma("unroll") for (int i = 0; i < NVC; ++i) { const int c = tid + NTHR * i; const int v = c >> 3, cc = c & 7; rv[i] = *(const u32x4*)(VT + (size_t)v * S + (KT_) * 64 + cc * 8); } }
#define AT_SWRITE(BUF_) { \
    _Pragma("unroll") for (int i = 0; i < NKC; ++i) { const int c = tid + NTHR * i; const int key = c / (KW / 8), cc = c % (KW / 8); *(u32x4*)(Ks + (BUF_) * 64 * KP + key * KP + cc * 8) = rk[i]; } \
    _Pragma("unroll") for (int i = 0; i < NVC; ++i) { const int c = tid + NTHR * i; const int v = c >> 3, cc = c & 7; \
      bf16_t* vd = Vs + (BUF_) * DV * 72 + v * 72 + (cc >> 1) * 16 + (cc & 1) * 4; \
      u32x2 lo_, hi_; lo_.x = rv[i].x; lo_.y = rv[i].y; hi_.x = rv[i].z; hi_.y = rv[i].w; *(u32x2*)vd = lo_; *(u32x2*)(vd + 8) = hi_; } }
  AT_GLOAD(0)
  AT_SWRITE(0)
  AT_GLOAD(1)
  __syncthreads();
  for (int kt = 0; kt < nk; ++kt) {
    const int buf = kt & 1;
    if (kt + 1 < nk) AT_SWRITE(buf ^ 1)
    if (kt + 2 < nk) AT_GLOAD(kt + 2)
    const bf16_t* Kb = Ks + buf * 64 * KP;
    const bf16_t* Vb = Vs + buf * DV * 72;
    f32x16 st[2];
    __builtin_amdgcn_s_setprio(1);
#pragma unroll
    for (int kb = 0; kb < 2; ++kb) {
#pragma unroll
      for (int i = 0; i < 16; ++i) st[kb][i] = 0.f;
#pragma unroll
      for (int ks = 0; ks < 4; ++ks) {
        bf16x8 kf = *(const bf16x8*)(Kb + (kb * 32 + l31) * KP + kwoff + ks * 16 + hf * 8);
        st[kb] = mfma32(kf, qf[ks], st[kb]);
      }
    }
    __builtin_amdgcn_s_setprio(0);
    float mx = st[0][0];
#pragma unroll
    for (int i = 0; i < 16; ++i) { mx = fmaxf(mx, st[0][i]); mx = fmaxf(mx, st[1][i]); }
    mx = fmaxf(mx, __shfl_xor(mx, 32));
    const float sc = mx * C;
    if (__builtin_amdgcn_ballot_w64(sc > m + 8.f) != 0ull) {
      const float mnew = fmaxf(m, sc);
      const float alpha = __builtin_amdgcn_exp2f(m - mnew);
      m = mnew; lsum *= alpha;
#pragma unroll
      for (int vb = 0; vb < NV; ++vb)
#pragma unroll
        for (int i = 0; i < 16; ++i) o[vb][i] *= alpha;
    }
    float ps = 0.f;
#pragma unroll
    for (int kb = 0; kb < 2; ++kb)
#pragma unroll
      for (int i = 0; i < 16; ++i) { const float pv = __builtin_amdgcn_exp2f(st[kb][i] * C - m); st[kb][i] = pv; ps += pv; }
    lsum += ps;
    bf16x8 pb[4];
#pragma unroll
    for (int j = 0; j < 4; ++j) {
      const int kb = j >> 1, base = (j & 1) * 8;
      u32x4 u; u.x = pk2(st[kb][base], st[kb][base + 1]); u.y = pk2(st[kb][base + 2], st[kb][base + 3]);
      u.z = pk2(st[kb][base + 4], st[kb][base + 5]); u.w = pk2(st[kb][base + 6], st[kb][base + 7]);
      pb[j] = __builtin_bit_cast(bf16x8, u);
    }
    __builtin_amdgcn_s_setprio(1);
#pragma unroll
    for (int vb = 0; vb < NV; ++vb)
#pragma unroll
      for (int j = 0; j < 4; ++j) {
        const bf16x8 vf = *(const bf16x8*)(Vb + (vb * 32 + l31) * 72 + j * 16 + 8 * hf);
        o[vb] = mfma32(vf, pb[j], o[vb]);
      }
    __builtin_amdgcn_s_setprio(0);
    __syncthreads();
  }
#undef AT_GLOAD
#undef AT_SWRITE
  const float lt = lsum + __shfl_xor(lsum, 32);
  const float inv = 1.f / lt;
  if (!ISA) {
#pragma unroll
    for (int vb = 0; vb < NV; ++vb)
#pragma unroll
      for (int g = 0; g < 4; ++g)
        store_bf4(outp + (size_t)l31 * 512 + vb * 32 + 8 * g + 4 * hf, o[vb][4 * g] * inv, o[vb][4 * g + 1] * inv, o[vb][4 * g + 2] * inv, o[vb][4 * g + 3] * inv);
  } else {
    __syncthreads();
    float* XS = (float*)smem;
    const int comp = w >> 2;
    const float lam = p.LAM()[l];
    if (comp == 1) {
      const float sc = inv * lam;
#pragma unroll
      for (int vb = 0; vb < NV; ++vb)
#pragma unroll
        for (int i = 0; i < 16; ++i) XS[((w & 3) * 64 + vb * 16 + i) * 64 + lane] = o[vb][i] * sc;
    }
    __syncthreads();
    if (comp == 0) {
      float ss = 0.f;
#pragma unroll
      for (int vb = 0; vb < NV; ++vb)
#pragma unroll
        for (int i = 0; i < 16; ++i) { const float v = o[vb][i] * inv - XS[((w & 3) * 64 + vb * 16 + i) * 64 + lane]; o[vb][i] = v; ss += v * v; }
      ss += __shfl_xor(ss, 32);
      const float lam_init = 0.8f - 0.6f * expf(-0.3f * (float)l);
      const float r = rsqrtf(ss * (1.f / 128.f) + EPSV) * (1.f - lam_init);
      const float* sw = p.in[I_SUBLN] + l * 128;
#pragma unroll
      for (int vb = 0; vb < NV; ++vb)
#pragma unroll
        for (int g = 0; g < 4; ++g) {
          f32x4 w4 = *(const f32x4*)(sw + vb * 32 + 8 * g + 4 * hf);
          store_bf4(outp + (size_t)l31 * 512 + vb * 32 + 8 * g + 4 * hf, o[vb][4 * g] * r * w4[0], o[vb][4 * g + 1] * r * w4[1], o[vb][4 * g + 2] * r * w4[2], o[vb][4 * g + 3] * r * w4[3]);
        }
    }
  }
}

__device__ __forceinline__ void hgrn_item(const Params& p, int l, bool lat, int b, int h, int dir, char* smem) {
  const int tid = opaque_tid(), lane = tid & 63, w = tid >> 6, l31 = lane & 31, hf = lane >> 5;
  bf16_t* QI = (bf16_t*)smem;
  bf16_t* QD = QI + 64 * 136;
  bf16_t* KD = QD + 64 * 136;
  bf16_t* QO = KD + 64 * 136;
  bf16_t* KO = QO + 32 * 136;
  bf16_t* KET = KO + 32 * 136;
  bf16_t* VTs = KET + 128 * 72;
  bf16_t* STs = VTs + 128 * 72;
  float* TOT = (float*)(STs + 128 * 136);
  float* BEND = TOT + 16 * 128;
  bf16_t* PP = (bf16_t*)(BEND + 128);
  const int T = lat ? 2048 : 256, nc = T >> 6;
  const int tok0 = lat ? NPR + b * 2048 : b * 256;
  const bf16_t* KK = dir ? p.KKB() : p.KKF();
  const float* LOGF = dir ? p.LOGFB() : p.LOGFF();
  bf16_t* OD = (bf16_t*)(dir ? p.OB() : p.OF());
  const int vb = w & 3, kp = w >> 2, tbk = w >> 2;
  const int tg = tid >> 5, kc = tid & 31;
  const size_t colo = (size_t)h * 128 + 4 * kc;
  f32x16 sacc[2];
  if (lat) {
    const float* s0 = p.in[I_ST] + ((size_t)((b * 4 + l) * 2 + dir) * 4 + h) * 16384;
#pragma unroll
    for (int q = 0; q < 2; ++q) {
      const int k = (2 * kp + q) * 32 + l31;
#pragma unroll
      for (int g = 0; g < 4; ++g) {
        f32x4 v4 = *(const f32x4*)(s0 + (size_t)k * 128 + vb * 32 + 8 * g + 4 * hf);
        sacc[q][4 * g] = v4[0]; sacc[q][4 * g + 1] = v4[1]; sacc[q][4 * g + 2] = v4[2]; sacc[q][4 * g + 3] = v4[3];
      }
    }
  } else {
#pragma unroll
    for (int q = 0; q < 2; ++q)
#pragma unroll
      for (int i = 0; i < 16; ++i) sacc[q][i] = 0.f;
  }
  f32x4 lf0, lf1, lf2, lf3; u32x2 rq0, rq1, rq2, rq3, rk0, rk1, rk2, rk3, rv0, rv1, rv2, rv3;
#define HG_OFF(cc, i) ((size_t)(tok0 + (dir ? T - 1 - ((cc) * 64 + 4 * tg + (i)) : (cc) * 64 + 4 * tg + (i))) * 512 + colo)
#define HG_LOAD(cc) { \
    const size_t o0 = HG_OFF(cc, 0), o1 = HG_OFF(cc, 1), o2 = HG_OFF(cc, 2), o3 = HG_OFF(cc, 3); \
    lf0 = *(const f32x4*)(LOGF + o0); lf1 = *(const f32x4*)(LOGF + o1); lf2 = *(const f32x4*)(LOGF + o2); lf3 = *(const f32x4*)(LOGF + o3); \
    rq0 = *(const u32x2*)(p.BQ() + o0); rq1 = *(const u32x2*)(p.BQ() + o1); rq2 = *(const u32x2*)(p.BQ() + o2); rq3 = *(const u32x2*)(p.BQ() + o3); \
    rk0 = *(const u32x2*)(KK + o0); rk1 = *(const u32x2*)(KK + o1); rk2 = *(const u32x2*)(KK + o2); rk3 = *(const u32x2*)(KK + o3); \
    rv0 = *(const u32x2*)(p.BI() + o0); rv1 = *(const u32x2*)(p.BI() + o1); rv2 = *(const u32x2*)(p.BI() + o2); rv3 = *(const u32x2*)(p.BI() + o3); }
  if (w == 3) {
#pragma unroll
    for (int g = 0; g < 4; ++g) store_bf4(PP + l31 * 72 + 32 + 8 * g + 4 * hf, 0.f, 0.f, 0.f, 0.f);
  }
  HG_LOAD(0)
  for (int c = 0; c < nc; ++c) {
    const f32x4 c0 = lf0, c1 = c0 + lf1, c2 = c1 + lf2, c3 = c2 + lf3;
    *(f32x4*)(TOT + tg * 128 + 4 * kc) = c3;
    __syncthreads();
    {
      f32x4 run = {0.f, 0.f, 0.f, 0.f}, pre = run, r15 = run, r31 = run, r47 = run, r63;
#pragma unroll 1
      for (int gq = 0; gq < 4; ++gq) {
#pragma unroll
        for (int gi = 0; gi < 4; ++gi) {
          const int g = gq * 4 + gi;
          const f32x4 tv = *(const f32x4*)(TOT + g * 128 + 4 * kc);
          if (g < tg) pre += tv;
          run += tv;
        }
        if (gq == 0) r15 = run;
        if (gq == 1) r31 = run;
        if (gq == 2) r47 = run;
      }
      r63 = run;
      const bool lo = __builtin_amdgcn_readfirstlane(tid >> 6) < 4;
      const f32x4 refd = lo ? r15 : r47;
      f32x4 e_ref, e_end, e_off;
#pragma unroll
      for (int ch = 0; ch < 4; ++ch) {
        e_ref[ch] = __expf(refd[ch]); e_end[ch] = __expf(r63[ch] - refd[ch]);
        e_off[ch] = __expf(lo ? r31[ch] - r15[ch] : r47[ch] - r31[ch]);
      }
      if (tg == 0) { f32x4 be; be[0] = __expf(r63[0]); be[1] = __expf(r63[1]); be[2] = __expf(r63[2]); be[3] = __expf(r63[3]); *(f32x4*)(BEND + 4 * kc) = be; }
      float ket[4][4];
#define HG_ELEM(i, ci, rq, rk) { \
      const f32x4 bt = pre + ci; \
      const float qv[4] = {__uint_as_float(rq.x << 16), __uint_as_float(rq.x & 0xffff0000u), __uint_as_float(rq.y << 16), __uint_as_float(rq.y & 0xffff0000u)}; \
      const float kv[4] = {__uint_as_float(rk.x << 16), __uint_as_float(rk.x & 0xffff0000u), __uint_as_float(rk.y << 16), __uint_as_float(rk.y & 0xffff0000u)}; \
      float qd[4], kd[4], qi[4], xo[4]; \
      _Pragma("unroll") for (int ch = 0; ch < 4; ++ch) { \
        const float d = bt[ch] - refd[ch]; \
        const float E1 = __expf(fminf(d, 80.f)), E2 = __expf(fminf(-d, 80.f)); \
        qd[ch] = qv[ch] * E1; kd[ch] = kv[ch] * E2; qi[ch] = qd[ch] * e_ref[ch]; ket[ch][i] = kd[ch] * e_end[ch]; \
        xo[ch] = (lo ? kd[ch] : qd[ch]) * e_off[ch]; } \
      const int t = 4 * tg + (i); \
      store_bf4(QI + t * 136 + 4 * kc, qi[0], qi[1], qi[2], qi[3]); \
      store_bf4(QD + t * 136 + 4 * kc, qd[0], qd[1], qd[2], qd[3]); \
      store_bf4(KD + t * 136 + 4 * kc, kd[0], kd[1], kd[2], kd[3]); \
      store_bf4((lo ? KO + t * 136 : QO + (t - 32) * 136) + 4 * kc, xo[0], xo[1], xo[2], xo[3]); }
      __builtin_amdgcn_sched_barrier(0);
      HG_ELEM(0, c0, rq0, rk0)
      __builtin_amdgcn_sched_barrier(0);
      HG_ELEM(1, c1, rq1, rk1)
      __builtin_amdgcn_sched_barrier(0);
      HG_ELEM(2, c2, rq2, rk2)
      __builtin_amdgcn_sched_barrier(0);
      HG_ELEM(3, c3, rq3, rk3)
      __builtin_amdgcn_sched_barrier(0);
#pragma unroll
      for (int ch = 0; ch < 4; ++ch) store_bf4(KET + (4 * kc + ch) * 72 + 4 * tg, ket[ch][0], ket[ch][1], ket[ch][2], ket[ch][3]);
      {
        u32x2 o;
        o.x = (rv0.x & 0xffffu) | (rv1.x << 16); o.y = (rv2.x & 0xffffu) | (rv3.x << 16); *(u32x2*)(VTs + (4 * kc + 0) * 72 + 4 * tg) = o;
        o.x = (rv0.x >> 16) | (rv1.x & 0xffff0000u); o.y = (rv2.x >> 16) | (rv3.x & 0xffff0000u); *(u32x2*)(VTs + (4 * kc + 1) * 72 + 4 * tg) = o;
        o.x = (rv0.y & 0xffffu) | (rv1.y << 16); o.y = (rv2.y & 0xffffu) | (rv3.y << 16); *(u32x2*)(VTs + (4 * kc + 2) * 72 + 4 * tg) = o;
        o.x = (rv0.y >> 16) | (rv1.y & 0xffff0000u); o.y = (rv2.y >> 16) | (rv3.y & 0xffff0000u); *(u32x2*)(VTs + (4 * kc + 3) * 72 + 4 * tg) = o;
      }
      if (c + 1 < nc) HG_LOAD(c + 1)
#pragma unroll
      for (int q = 0; q < 2; ++q) {
        const int k = (2 * kp + q) * 32 + l31;
#pragma unroll
        for (int i = 0; i < 16; ++i) STs[(vb * 32 + 8 * (i >> 2) + 4 * hf + (i & 3)) * 136 + k] = f2bf(sacc[q][i]);
      }
    }
    __syncthreads();
    f32x16 pacc;
#pragma unroll
    for (int i = 0; i < 16; ++i) pacc[i] = 0.f;
    if (w < 3) {
      const bf16_t* Ap = w == 0 ? KD : (w == 1 ? KD + 32 * 136 : KO);
      const bf16_t* Bp = w == 0 ? QD : (w == 1 ? QD + 32 * 136 : QO);
      bf16x8 kf[8], qf[8];
#pragma unroll
      for (int ks = 0; ks < 8; ++ks) { kf[ks] = *(const bf16x8*)(Ap + l31 * 136 + ks * 16 + hf * 8); qf[ks] = *(const bf16x8*)(Bp + l31 * 136 + ks * 16 + hf * 8); }
#pragma unroll
      for (int ks = 0; ks < 8; ++ks) pacc = mfma32(kf[ks], qf[ks], pacc);
    }
    if (w < 3) {
      const int tb = (w == 1 || w == 2) ? 1 : 0, sb = (w == 1) ? 1 : 0;
      const bool diag = w < 2;
#pragma unroll
      for (int g = 0; g < 4; ++g) {
        const int sl = 8 * g + 4 * hf;
        float v[4];
#pragma unroll
        for (int e = 0; e < 4; ++e) v[e] = (!diag || l31 >= sl + e) ? pacc[4 * g + e] : 0.f;
        store_bf4(PP + (tb * 32 + l31) * 72 + sb * 32 + sl, v[0], v[1], v[2], v[3]);
      }
    }
    __syncthreads();
    {
      f32x16 oacc;
#pragma unroll
      for (int i = 0; i < 16; ++i) oacc[i] = 0.f;
      {
        bf16x8 af[8], bfr[8];
#pragma unroll
        for (int ks = 0; ks < 8; ++ks) { af[ks] = *(const bf16x8*)(STs + (vb * 32 + l31) * 136 + ks * 16 + hf * 8); bfr[ks] = *(const bf16x8*)(QI + (tbk * 32 + l31) * 136 + ks * 16 + hf * 8); }
#pragma unroll
        for (int ks = 0; ks < 8; ++ks) oacc = mfma32(af[ks], bfr[ks], oacc);
      }
      {
        bf16x8 af[4], bfr[4];
#pragma unroll
        for (int ks = 0; ks < 4; ++ks) { af[ks] = *(const bf16x8*)(VTs + (vb * 32 + l31) * 72 + ks * 16 + hf * 8); bfr[ks] = *(const bf16x8*)(PP + (tbk * 32 + l31) * 72 + ks * 16 + hf * 8); }
        oacc = mfma32(af[0], bfr[0], oacc); oacc = mfma32(af[1], bfr[1], oacc);
        if (__builtin_amdgcn_readfirstlane(tbk) != 0) { oacc = mfma32(af[2], bfr[2], oacc); oacc = mfma32(af[3], bfr[3], oacc); }
      }
      const int j = tbk * 32 + l31;
      const int tt = dir ? T - 1 - (c * 64 + j) : c * 64 + j;
      bf16_t* od = OD + (size_t)(tok0 + tt) * 512 + h * 128 + vb * 32;
#pragma unroll
      for (int g = 0; g < 4; ++g) store_bf4(od + 8 * g + 4 * hf, oacc[4 * g], oacc[4 * g + 1], oacc[4 * g + 2], oacc[4 * g + 3]);
    }
    {
      bf16x8 af[4], bk[2][4];
#pragma unroll
      for (int ks = 0; ks < 4; ++ks) {
        af[ks] = *(const bf16x8*)(VTs + (vb * 32 + l31) * 72 + ks * 16 + hf * 8);
        bk[0][ks] = *(const bf16x8*)(KET + ((2 * kp) * 32 + l31) * 72 + ks * 16 + hf * 8);
        bk[1][ks] = *(const bf16x8*)(KET + ((2 * kp + 1) * 32 + l31) * 72 + ks * 16 + hf * 8);
      }
#pragma unroll
      for (int q = 0; q < 2; ++q) {
        const float dec = BEND[(2 * kp + q) * 32 + l31];
#pragma unroll
        for (int i = 0; i < 16; ++i) sacc[q][i] *= dec;
      }
#pragma unroll
      for (int ks = 0; ks < 4; ++ks) { sacc[0] = mfma32(af[ks], bk[0][ks], sacc[0]); sacc[1] = mfma32(af[ks], bk[1][ks], sacc[1]); }
    }
    __syncthreads();
  }
#undef HG_OFF
#undef HG_LOAD
#undef HG_ELEM
  if (!lat) {
    float* sd = p.out + OUT_HG + ((size_t)((b * 4 + l) * 2 + dir) * 4 + h) * 16384;
#pragma unroll
    for (int q = 0; q < 2; ++q) {
      const int k = (2 * kp + q) * 32 + l31;
#pragma unroll
      for (int g = 0; g < 4; ++g)
        *(f32x4*)(sd + (size_t)k * 128 + vb * 32 + 8 * g + 4 * hf) = (f32x4){sacc[q][4 * g], sacc[q][4 * g + 1], sacc[q][4 * g + 2], sacc[q][4 * g + 3]};
    }
  }
}

__device__ __forceinline__ void phase_mixers(const Params& p, int l, char* smem) {
  volatile int* bc = (volatile int*)(smem + SMEM_BYTES - 16);
  const int w = opaque_tid() >> 6;
#ifdef STATIC_SCHED
  for (int it = blockIdx.x; it < 928; it += gridDim.x) {
    __syncthreads();
    int idx = it;
#else
  for (;;) {
    __syncthreads();
    if (opaque_tid() == 0) *bc = (int)atomicAdd(p.CTR() + l, 1u);
    __syncthreads();
    int idx = *bc;
    if (idx >= 928) break;
#endif
    if (idx < 160) {
      const bool lat = idx < 32;
      if (!lat) idx -= 32;
      hgrn_item(p, l, lat, idx >> 3, (idx >> 1) & 3, idx & 1, smem);
    } else if (idx < 416 || (idx >= 672 && idx < 800)) {
      const bool lat = idx < 416;
      int b, h, qt;
      if (lat) { idx -= 160; b = idx >> 6; h = (idx >> 4) & 3; qt = idx & 15; } else { idx -= 672; b = idx >> 3; h = (idx >> 1) & 3; qt = idx & 1; }
      const int S = lat ? SLAT : 256;
      const int row = (lat ? NPR + b * 2048 : b * 256) + qt * 128 + 32 * (w & 3), comp = w >> 2;
      const bf16_t* Kb = lat ? p.KA_lat() : p.KA_ctx();
      const bf16_t* Vb = lat ? p.VTA_lat() : p.VTA_ctx();
      attn_item<128, 128, true>(p, l, p.QA() + (size_t)row * 512 + h * 128 + comp * 64, Kb + (size_t)b * S * 512 + h * 128, 512, comp * 64,
                                Vb + ((size_t)b * 512 + h * 128) * S, S, p.OA() + (size_t)row * 512 + h * 128, smem);
    } else {
      const bool lat = idx < 672;
      int b, kvh, qt;
      if (lat) { idx -= 416; b = idx >> 6; kvh = (idx >> 5) & 1; qt = idx & 31; } else { idx -= 800; b = idx >> 3; kvh = (idx >> 2) & 1; qt = idx & 3; }
      const int S = lat ? SLAT : 256;
      const int row = (lat ? NPR + b * 2048 : b * 256) + qt * 64 + 32 * (w >> 2), hq = kvh * 4 + (w & 3);
      const bf16_t* Kb = lat ? p.KC_lat() : p.KC_ctx();
      const bf16_t* Vb = lat ? p.VTC_lat() : p.VTC_ctx();
      attn_item<64, 64, false>(p, l, p.QC() + (size_t)row * 512 + hq * 64, Kb + (size_t)b * S * 128 + kvh * 64, 128, 0,
                               Vb + ((size_t)b * 128 + kvh * 64) * S, S, p.OC() + (size_t)row * 512 + hq * 64, smem);
    }
  }
}

__device__ __forceinline__ void phase_gnorm(const Params& p, int l) {
  const int lane = opaque_tid() & 63, w = opaque_tid() >> 6;
  const float* gw = p.in[I_GNORM] + l * 128;
  for (int grp = blockIdx.x; grp < NT / 8; grp += gridDim.x) {
    const int row = grp * 8 + w;
    const size_t off = (size_t)row * 512 + lane * 8;
    const u32x4 fa = *(const u32x4*)((const bf16_t*)p.OF() + off), fb = *(const u32x4*)((const bf16_t*)p.OB() + off);
    float v[8]; float ss = 0.f;
    v[0] = __uint_as_float(fa.x << 16) + __uint_as_float(fb.x << 16); v[1] = __uint_as_float(fa.x & 0xffff0000u) + __uint_as_float(fb.x & 0xffff0000u);
    v[2] = __uint_as_float(fa.y << 16) + __uint_as_float(fb.y << 16); v[3] = __uint_as_float(fa.y & 0xffff0000u) + __uint_as_float(fb.y & 0xffff0000u);
    v[4] = __uint_as_float(fa.z << 16) + __uint_as_float(fb.z << 16); v[5] = __uint_as_float(fa.z & 0xffff0000u) + __uint_as_float(fb.z & 0xffff0000u);
    v[6] = __uint_as_float(fa.w << 16) + __uint_as_float(fb.w << 16); v[7] = __uint_as_float(fa.w & 0xffff0000u) + __uint_as_float(fb.w & 0xffff0000u);
#pragma unroll
    for (int e = 0; e < 8; ++e) ss += v[e] * v[e];
    ss += __shfl_xor(ss, 8); ss += __shfl_xor(ss, 4); ss += __shfl_xor(ss, 2); ss += __shfl_xor(ss, 1);
    const float r = rsqrtf(ss * (1.f / 128.f) + EPSV);
    const int vc = (lane & 15) * 8;
    uint4 g = *(const uint4*)(p.BG() + off);
    float bg[8] = {__uint_as_float(g.x << 16), __uint_as_float(g.x & 0xffff0000u), __uint_as_float(g.y << 16), __uint_as_float(g.y & 0xffff0000u),
                   __uint_as_float(g.z << 16), __uint_as_float(g.z & 0xffff0000u), __uint_as_float(g.w << 16), __uint_as_float(g.w & 0xffff0000u)};
    float o[8];
#pragma unroll
    for (int e = 0; e < 8; ++e) o[e] = v[e] * r * gw[vc + e] * bg[e];
    uint4 u; u.x = pk2(o[0], o[1]); u.y = pk2(o[2], o[3]); u.z = pk2(o[4], o[5]); u.w = pk2(o[6], o[7]);
    *(uint4*)(p.OBR() + off) = u;
  }
}

#define XB_TMO      128
#define XB_XCNT(j)  (256  + 64 * (j))
#define XB_XSUB(j)  (1280 + 64 * (j))
#define XB_XGEN(j)  (2304 + 64 * (j))
#define XB_TOP      3328
#define XB_TOPGEN   3392
#define XCD_BAR_WORDS 3456
#define XB_SPIN_CAP (1u << 18)
#define LAS __attribute__((address_space(3)))

__device__ __forceinline__ unsigned xb_ld(unsigned* p)              { return __hip_atomic_load(p, __ATOMIC_RELAXED, __HIP_MEMORY_SCOPE_AGENT); }
__device__ __forceinline__ unsigned xb_add(unsigned* p, unsigned v) { return __hip_atomic_fetch_add(p, v, __ATOMIC_RELAXED, __HIP_MEMORY_SCOPE_AGENT); }
__device__ __forceinline__ unsigned xb_xcc_id() { return (unsigned)__builtin_amdgcn_s_getreg((3 << 11) | 20) & 0xFu; }
#define XB_SPIN(cond, bar) do { unsigned _sp = 0; while (cond) { __builtin_amdgcn_s_sleep(1); \
    if ((++_sp & 255u) == 0u) { if (xb_ld(&(bar)[XB_TMO])) break; if (_sp > XB_SPIN_CAP) { atomicAdd(&(bar)[XB_TMO], 1u); break; } } } } while (0)

struct XcdBarrier {
    unsigned* bar; unsigned x;
    volatile LAS unsigned* st;
};

__device__ __forceinline__ XcdBarrier xcd_barrier_post(unsigned* bar, volatile LAS unsigned* st) {
    XcdBarrier b; b.bar = bar; b.x = xb_xcc_id(); b.st = st;
    if (threadIdx.x == 0) (void)xb_add(&bar[XB_XCNT(b.x)], 1u);
    return b;
}
__device__ __forceinline__ void xcd_barrier_complete(unsigned* bar, unsigned x, unsigned& nloc, unsigned& nx) {
    const unsigned G = gridDim.x * gridDim.y * gridDim.z;
    unsigned sum, cnt, mine, sp = 0u;
    for (;;) {
        sum = 0u; cnt = 0u; mine = 0u;
#pragma unroll
        for (unsigned j = 0; j < 16; ++j) { const unsigned c = xb_ld(&bar[XB_XCNT(j)]); sum += c; cnt += (c > 0u) ? 1u : 0u; mine = (j == x) ? c : mine; }
        if (sum == G) break;
        __builtin_amdgcn_s_sleep(1);
        if ((++sp & 255u) == 0u) { if (xb_ld(&bar[XB_TMO])) break; if (sp > XB_SPIN_CAP) { atomicAdd(&bar[XB_TMO], 1u); break; } }
    }
    nloc = mine > 0u ? mine : 1u; nx = cnt > 0u ? cnt : 1u;
}

__device__ __forceinline__ void xcd_barrier(const XcdBarrier& b) {
    asm volatile("s_waitcnt vmcnt(0)" ::: "memory");
    __syncthreads();
    if (threadIdx.x == 0) {
        unsigned* bar = b.bar;
        __builtin_amdgcn_s_waitcnt(0);
        unsigned nloc = b.st[0], nx = b.st[1];
        if (nloc == 0u) { xcd_barrier_complete(bar, b.x, nloc, nx); b.st[0] = nloc; b.st[1] = nx; }
        const unsigned old = xb_add(&bar[XB_XSUB(b.x)], 1u);
        const unsigned gen = old / nloc;
        if (old + 1u == (gen + 1u) * nloc) {
            __builtin_amdgcn_fence(__ATOMIC_RELEASE, "agent");
            asm volatile("s_waitcnt vmcnt(0)" ::: "memory");
            const unsigned og = xb_add(&bar[XB_TOP], 1u);
            const unsigned tg = og / nx;
            if (og + 1u == (tg + 1u) * nx) xb_add(&bar[XB_TOPGEN], 1u);
            else XB_SPIN(xb_ld(&bar[XB_TOPGEN]) == tg, bar);
            __builtin_amdgcn_fence(__ATOMIC_ACQUIRE, "agent");
            xb_add(&bar[XB_XGEN(b.x)], 1u);
            asm volatile("s_waitcnt vmcnt(0)" ::: "memory");
        } else {
            XB_SPIN(xb_ld(&bar[XB_XGEN(b.x)]) == gen, bar);
            __builtin_amdgcn_fence(__ATOMIC_ACQUIRE, "agent");
            asm volatile("s_waitcnt vmcnt(0)" ::: "memory");
        }
    }
    __syncthreads();
}


#ifndef DBG_STOP
#define DBG_STOP 1000
#endif
#define STOP_AT(n) if (DBG_STOP == (n)) return;
#ifndef REP_GEMM
#define REP_GEMM 1
#endif
__global__ void __launch_bounds__(512, 2) fwd_megakernel(Params p) {
  extern __shared__ __attribute__((aligned(16))) char smem[];
  cg::grid_group grid = cg::this_grid();
  PG8_LAS unsigned char* lds = (PG8_LAS unsigned char*)smem;
  volatile LAS unsigned* xst = (volatile LAS unsigned*)(lds + SMEM_BYTES - 32);
  if (threadIdx.x == 0) { xst[0] = 0u; xst[1] = 0u; }
  __syncthreads();
  const XcdBarrier xbar = xcd_barrier_post(p.BAR(), xst);
  phase0(p, smem);
  grid.sync();
  phase_rowwise(p, true, -1, 0, 0.f, 0, 0, 0, 0, 1);
  xcd_barrier(xbar);
#pragma unroll 1
  for (int l = 0; l < 4; ++l) {
    for (int rep_ = 0; rep_ < REP_GEMM; ++rep_) { { int lq = l; asm volatile("" : "+s"(lq)); phase_gemm_gu2(p, lq, 0, lds); } }
    xcd_barrier(xbar);
    for (int rep_ = 0; rep_ < REP_GEMM; ++rep_) { { int lq = l; asm volatile("" : "+s"(lq)); phase_gemm_y2(p, p.ACT(), DFF, p.WD() + (size_t)(lq * 2 + 0) * 1024 * DFF, lds); } }
    xcd_barrier(xbar);
    { int lq = l; asm volatile("" : "+s"(lq)); phase_rowwise(p, false, lq, 0, 0.5f, 2, lq, 1, 3, 4); }
    { int lq = l; asm volatile("" : "+s"(lq)); cache_convert(p, lq); }
    xcd_barrier(xbar);
    STOP_AT(1)
    for (int rep_ = 0; rep_ < REP_GEMM; ++rep_) { { int lq = l; asm volatile("" : "+s"(lq)); phase_gemm_win2(p, lq, lds); } }
    xcd_barrier(xbar);
    STOP_AT(2)
    { int lq = l; asm volatile("" : "+s"(lq)); phase_mixers(p, lq, smem); }
    xcd_barrier(xbar);
    STOP_AT(3)
#if DBG_STOP == 6 || DBG_STOP == 7 || DBG_STOP == 8
    {
      const size_t gt = (size_t)blockIdx.x * 256 + opaque_tid(), gs = (size_t)gridDim.x * 256;
      for (size_t i = gt; i < (size_t)NT * 512; i += gs) {
#if DBG_STOP == 6 || DBG_STOP == 7
        p.out[i] = bf2f(p.OA()[i]);
        p.out[(size_t)NT * 512 + i] = bf2f(p.OC()[i]);
#endif
#if DBG_STOP == 6 || DBG_STOP == 8
        p.out[OUT_AK + i] = p.OF()[i];
        p.out[OUT_AV + i] = p.OB()[i];
#endif
      }
      return;
    }
#endif
    { int lq = l; asm volatile("" : "+s"(lq)); phase_gnorm(p, lq); }
    xcd_barrier(xbar);
    for (int rep_ = 0; rep_ < REP_GEMM; ++rep_) { { int lq = l; asm volatile("" : "+s"(lq)); phase_gemm_br2(p, lq, lds); } }
    xcd_barrier(xbar);
    STOP_AT(4)
    for (int rep_ = 0; rep_ < REP_GEMM; ++rep_) { { int lq = l; asm volatile("" : "+s"(lq)); phase_gemm_y2(p, p.MERGED(), 1024, p.WOUT() + (size_t)lq * 1024 * 1024, lds); } }
    xcd_barrier(xbar);
    { int lq = l; asm volatile("" : "+s"(lq)); phase_rowwise(p, false, lq, 1, 1.0f, 5, lq, 2, 6, 7); }
    xcd_barrier(xbar);
    for (int rep_ = 0; rep_ < REP_GEMM; ++rep_) { { int lq = l; asm volatile("" : "+s"(lq)); phase_gemm_gu2(p, lq, 1, lds); } }
    xcd_barrier(xbar);
    for (int rep_ = 0; rep_ < REP_GEMM; ++rep_) { { int lq = l; asm volatile("" : "+s"(lq)); phase_gemm_y2(p, p.ACT(), DFF, p.WD() + (size_t)(lq * 2 + 1) * 1024 * DFF, lds); } }
    xcd_barrier(xbar);
    if (l < 3) { { int lq = l; asm volatile("" : "+s"(lq)); phase_rowwise(p, false, lq, 2, 0.5f, 8, lq + 1, 0, 0, 1); } xcd_barrier(xbar); }
    else { int lq = l; asm volatile("" : "+s"(lq)); phase_rowwise(p, false, lq, 2, 0.5f, 8, -1, 0, 0, 0); }
    STOP_AT(5)
  }
}

extern "C" void kernel_launch(void* const* d_in, const int* in_sizes, int n_in, void* d_out, int out_size, void* d_ws, size_t ws_size, hipStream_t stream) {
  static int grid_blocks = 0;
  if (!grid_blocks) {
    int dev = 0, cus = 0, per_cu = 0;
    hipGetDevice(&dev);
    hipDeviceGetAttribute(&cus, hipDeviceAttributeMultiprocessorCount, dev);
    hipFuncSetAttribute((const void*)fwd_megakernel, hipFuncAttributeMaxDynamicSharedMemorySize, SMEM_BYTES);
    hipOccupancyMaxActiveBlocksPerMultiprocessor(&per_cu, fwd_megakernel, NTHR, SMEM_BYTES);
    if (per_cu < 1) per_cu = 1;
    if (per_cu > 1) per_cu = 1;
    grid_blocks = cus * per_cu;
  }
  Params p{};
  for (int i = 0; i < 27; ++i) p.in[i] = (const float*)d_in[i];
  p.out = (float*)d_out;
  p.ws = (char*)d_ws;
  if (WS_TOTAL > ws_size) { fprintf(stderr, "workspace too small: need %zu have %zu\n", (size_t)WS_TOTAL, ws_size); return; }
  (void)hipMemsetAsync(p.ws + O_BAR, 0, (size_t)3456 * 4, stream);
  void* args[] = {&p};
  hipError_t e = hipLaunchCooperativeKernel((const void*)fwd_megakernel, dim3(grid_blocks), dim3(NTHR), args, SMEM_BYTES, stream);
  if (e != hipSuccess) fprintf(stderr, "cooperative launch failed: %s (grid %d)\n", hipGetErrorString(e), grid_blocks);
}
```
